# Optimizing an MI355X kernel written in HIP

```python
import math
import jax, jax.numpy as jnp
from jax import lax
import numpy as np

D_MODEL = 2048
BATCH = 4
SEQ = 8192
DEPTH = 4

ATTN_HEADS = 8
QK_DIM = 64
V_DIM = 2 * QK_DIM
ATTN_WIDTH = ATTN_HEADS * V_DIM
Q_BLOCK = 128
ROPE_THETA = 10000.0
SSM_WIDTH = D_MODEL // 2
SSM_GROUP = 16
SSM_GROUPS = SSM_WIDTH // SSM_GROUP
SSM_STATE = 64
SSM_CHUNK = 128
D_FF = 4 * D_MODEL
LN_EPS = 1e-5
RMS_EPS = 1e-5
DEEPNORM_ALPHA = (2.0 * DEPTH) ** 0.25
DEEPNORM_BETA = (8.0 * DEPTH) ** -0.25

Q_COLS = ATTN_HEADS * 2 * QK_DIM
K_COLS = ATTN_HEADS * 2 * QK_DIM
V_COLS = ATTN_WIDTH
U_COLS = SSM_WIDTH
G_COLS = D_MODEL
OFF_K = Q_COLS
OFF_V = OFF_K + K_COLS
OFF_U = OFF_V + V_COLS
OFF_GA = OFF_U + U_COLS
OFF_GS = OFF_GA + G_COLS
IN_COLS = OFF_GS + G_COLS

kernel_name = "gated_diffattn_s5_hybrid_deepnorm"


def _lambda_init(layer):
    return 0.8 - 0.6 * math.exp(-0.3 * layer)


def layer_norm(x, g, b):
    xf = x.astype(jnp.float32)
    mu = jnp.mean(xf, axis=-1, keepdims=True)
    xc = xf - mu
    var = jnp.mean(jnp.square(xc), axis=-1, keepdims=True)
    y = xc * lax.rsqrt(var + LN_EPS) * g.astype(jnp.float32) + b.astype(jnp.float32)
    return y.astype(x.dtype)


def rope_tables(positions, dtype):
    inv = ROPE_THETA ** (-jnp.arange(0, QK_DIM, 2, dtype=jnp.float32) / QK_DIM)
    ang = positions.astype(jnp.float32)[..., None] * inv
    return jnp.cos(ang).astype(dtype), jnp.sin(ang).astype(dtype)


def apply_rope(t, cos, sin):
    c = cos[:, :, None, None, :]
    s = sin[:, :, None, None, :]
    half = QK_DIM // 2
    t1, t2 = t[..., :half], t[..., half:]
    return jnp.concatenate([t1 * c - t2 * s, t2 * c + t1 * s], axis=-1)


def diff_attention(q, k, v, lam, lam_init, subln_g):
    bsz, seq = q.shape[0], q.shape[1]
    n_blocks = seq // Q_BLOCK
    scale = QK_DIM ** -0.5
    kpos = jnp.arange(seq)

    def block(i):
        start = i * Q_BLOCK
        qb = lax.dynamic_slice_in_dim(q, start, Q_BLOCK, axis=1)
        s = jnp.einsum('bqhcd,bkhcd->bhcqk', qb, k).astype(jnp.float32) * scale
        qpos = start + jnp.arange(Q_BLOCK)
        mask = kpos[None, :] <= qpos[:, None]
        p = jax.nn.softmax(jnp.where(mask, s, -jnp.inf), axis=-1)
        w = p[:, :, 0] - lam * p[:, :, 1]
        return jnp.einsum('bhqk,bkhe->bqhe', w.astype(v.dtype), v)

    out = lax.map(block, jnp.arange(n_blocks))
    out = jnp.moveaxis(out, 0, 1).reshape(bsz, seq, ATTN_HEADS, V_DIM)
    of = out.astype(jnp.float32)
    of = of * lax.rsqrt(jnp.mean(jnp.square(of), axis=-1, keepdims=True) + RMS_EPS)
    of = of * subln_g.astype(jnp.float32) * (1.0 - lam_init)
    return of.astype(v.dtype).reshape(bsz, seq, ATTN_WIDTH)


def _complex_affine_combine(e1, e2):
    a1r, a1i, b1r, b1i = e1
    a2r, a2i, b2r, b2i = e2
    ar = a2r * a1r - a2i * a1i
    ai = a2r * a1i + a2i * a1r
    br = a2r * b1r - a2i * b1i + b2r
    bi = a2r * b1i + a2i * b1r + b2i
    return (ar, ai, br, bi)


def s5_ssm(u, a_re, a_im, log_dt, b_re, b_im, c_re, c_im, d_skip, w_glu):
    out_dtype = u.dtype
    f32 = jnp.float32
    uf = u.astype(f32)
    a_re = a_re.astype(f32); a_im = a_im.astype(f32)
    b_re = b_re.astype(f32); b_im = b_im.astype(f32)
    c_re = c_re.astype(f32); c_im = c_im.astype(f32)
    dt = jnp.exp(log_dt.astype(f32))[:, None]
    mag = jnp.exp(dt * a_re)
    ab_re = mag * jnp.cos(dt * a_im)
    ab_im = mag * jnp.sin(dt * a_im)
    den = jnp.square(a_re) + jnp.square(a_im)
    nr, ni = ab_re - 1.0, ab_im
    z_re = (nr * a_re + ni * a_im) / den
    z_im = (ni * a_re - nr * a_im) / den
    bb_re = z_re[..., None] * b_re - z_im[..., None] * b_im
    bb_im = z_re[..., None] * b_im + z_im[..., None] * b_re

    bsz, seq = uf.shape[0], uf.shape[1]
    n_chunks = seq // SSM_CHUNK
    uc = jnp.moveaxis(uf.reshape(bsz, n_chunks, SSM_CHUNK, SSM_GROUPS, SSM_GROUP), 1, 0)
    el_shape = (bsz, SSM_CHUNK, SSM_GROUPS, SSM_STATE)
    a_el_re = jnp.broadcast_to(ab_re, el_shape)
    a_el_im = jnp.broadcast_to(ab_im, el_shape)

    def step(carry, u_chunk):
        h_re, h_im = carry
        bu_re = jnp.einsum('blgh,gph->blgp', u_chunk, bb_re)
        bu_im = jnp.einsum('blgh,gph->blgp', u_chunk, bb_im)
        acum_re, acum_im, s_re, s_im = lax.associative_scan(
            _complex_affine_combine, (a_el_re, a_el_im, bu_re, bu_im), axis=1)
        x_re = s_re + acum_re * h_re[:, None] - acum_im * h_im[:, None]
        x_im = s_im + acum_re * h_im[:, None] + acum_im * h_re[:, None]
        y = (jnp.einsum('blgp,ghp->blgh', x_re, c_re)
             - jnp.einsum('blgp,ghp->blgh', x_im, c_im))
        return (x_re[:, -1], x_im[:, -1]), y

    init = (jnp.zeros((bsz, SSM_GROUPS, SSM_STATE), f32),
            jnp.zeros((bsz, SSM_GROUPS, SSM_STATE), f32))
    _, ys = lax.scan(step, init, uc)
    y = jnp.moveaxis(ys, 0, 1).reshape(bsz, seq, SSM_GROUPS, SSM_GROUP)
    y = y + d_skip.astype(f32) * uf
    g = jax.nn.gelu(y).reshape(bsz, seq, SSM_WIDTH)
    g = g * jax.nn.sigmoid(g @ w_glu.astype(f32))
    return g.astype(out_dtype)


def hybrid_mixer(x, cos, sin, w_in, lam_qk, lam_init, subln_g,
                 a_re, a_im, log_dt, b_re, b_im, c_re, c_im, d_skip, w_glu,
                 w_attn_up, w_ssm_up, w_out):
    bsz, seq, _ = x.shape
    q = (x @ w_in[:, :OFF_K]).reshape(bsz, seq, ATTN_HEADS, 2, QK_DIM)
    k = (x @ w_in[:, OFF_K:OFF_V]).reshape(bsz, seq, ATTN_HEADS, 2, QK_DIM)
    v = (x @ w_in[:, OFF_V:OFF_U]).reshape(bsz, seq, ATTN_HEADS, V_DIM)
    u = (x @ w_in[:, OFF_U:OFF_GA]).reshape(bsz, seq, SSM_GROUPS, SSM_GROUP)
    gate_a = jax.nn.sigmoid(x @ w_in[:, OFF_GA:OFF_GS])
    gate_s = jax.nn.sigmoid(x @ w_in[:, OFF_GS:])
    q = apply_rope(q, cos, sin)
    k = apply_rope(k, cos, sin)
    lq = lam_qk.astype(jnp.float32)
    lam = (jnp.exp(jnp.sum(lq[0] * lq[1])) - jnp.exp(jnp.sum(lq[2] * lq[3])) + lam_init)
    attn = diff_attention(q, k, v, lam, lam_init, subln_g)
    ssm = s5_ssm(u, a_re, a_im, log_dt, b_re, b_im, c_re, c_im, d_skip, w_glu)
    merged = gate_a * (attn @ w_attn_up) + gate_s * (ssm @ w_ssm_up)
    return merged @ w_out


def setup_inputs(seed: int = 0) -> dict:
    key = jax.random.key(seed)
    ks = jax.random.split(key, 24)
    f32 = jnp.float32
    nrm = lambda k, shape, std: jax.random.normal(k, shape, f32) * std
    x = jax.random.normal(ks[0], (BATCH, SEQ, D_MODEL), f32)
    positions = jnp.broadcast_to(jnp.arange(SEQ, dtype=jnp.int32)[None, :], (BATCH, SEQ))
    w_in = nrm(ks[1], (DEPTH, D_MODEL, IN_COLS), D_MODEL ** -0.5)
    lambda_qk = nrm(ks[2], (DEPTH, 4, QK_DIM), 0.1)
    subln_g = 1.0 + nrm(ks[3], (DEPTH, V_DIM), 0.02)
    ssm_a_re = -0.5 + nrm(ks[4], (DEPTH, SSM_GROUPS, SSM_STATE), 0.01)
    ssm_a_im = jnp.broadcast_to(jnp.pi * jnp.arange(SSM_STATE, dtype=f32), (DEPTH, SSM_GROUPS, SSM_STATE))
    ssm_log_dt = jax.random.uniform(ks[5], (DEPTH, SSM_GROUPS), f32, math.log(1e-3), math.log(1e-1))
    ssm_b_re = nrm(ks[6], (DEPTH, SSM_GROUPS, SSM_STATE, SSM_GROUP), (2.0 * SSM_GROUP) ** -0.5)
    ssm_b_im = nrm(ks[7], (DEPTH, SSM_GROUPS, SSM_STATE, SSM_GROUP), (2.0 * SSM_GROUP) ** -0.5)
    ssm_c_re = nrm(ks[8], (DEPTH, SSM_GROUPS, SSM_GROUP, SSM_STATE), 0.5 ** 0.5)
    ssm_c_im = nrm(ks[9], (DEPTH, SSM_GROUPS, SSM_GROUP, SSM_STATE), 0.5 ** 0.5)
    ssm_d = nrm(ks[10], (DEPTH, SSM_GROUPS, SSM_GROUP), 1.0)
    w_glu = nrm(ks[11], (DEPTH, SSM_WIDTH, SSM_WIDTH), SSM_WIDTH ** -0.5)
    w_attn_up = nrm(ks[12], (DEPTH, ATTN_WIDTH, D_MODEL), ATTN_WIDTH ** -0.5)
    w_ssm_up = nrm(ks[13], (DEPTH, SSM_WIDTH, D_MODEL), SSM_WIDTH ** -0.5)
    w_out = nrm(ks[14], (DEPTH, D_MODEL, D_MODEL), D_MODEL ** -0.5 * DEEPNORM_BETA)
    ln1_g = 1.0 + nrm(ks[15], (DEPTH, D_MODEL), 0.02)
    ln1_b = nrm(ks[16], (DEPTH, D_MODEL), 0.02)
    ln2_g = 1.0 + nrm(ks[17], (DEPTH, D_MODEL), 0.02)
    ln2_b = nrm(ks[18], (DEPTH, D_MODEL), 0.02)
    w_mlp_up = nrm(ks[19], (DEPTH, D_MODEL, D_FF), D_MODEL ** -0.5)
    w_mlp_down = nrm(ks[20], (DEPTH, D_FF, D_MODEL), D_FF ** -0.5 * DEEPNORM_BETA)
    return {"x": x, "positions": positions, "w_in": w_in, "lambda_qk": lambda_qk,
            "subln_g": subln_g, "ssm_a_re": ssm_a_re, "ssm_a_im": ssm_a_im,
            "ssm_log_dt": ssm_log_dt, "ssm_b_re": ssm_b_re, "ssm_b_im": ssm_b_im,
            "ssm_c_re": ssm_c_re, "ssm_c_im": ssm_c_im, "ssm_d": ssm_d, "w_glu": w_glu,
            "w_attn_up": w_attn_up, "w_ssm_up": w_ssm_up, "w_out": w_out,
            "ln1_g": ln1_g, "ln1_b": ln1_b, "ln2_g": ln2_g, "ln2_b": ln2_b,
            "w_mlp_up": w_mlp_up, "w_mlp_down": w_mlp_down}


def reference(x, positions, w_in, lambda_qk, subln_g, ssm_a_re, ssm_a_im, ssm_log_dt,
              ssm_b_re, ssm_b_im, ssm_c_re, ssm_c_im, ssm_d, w_glu, w_attn_up, w_ssm_up,
              w_out, ln1_g, ln1_b, ln2_g, ln2_b, w_mlp_up, w_mlp_down):
    cos, sin = rope_tables(positions, x.dtype)
    for l in range(DEPTH):
        lam_init = _lambda_init(l)
        mix = hybrid_mixer(x, cos, sin, w_in[l], lambda_qk[l], lam_init, subln_g[l],
                           ssm_a_re[l], ssm_a_im[l], ssm_log_dt[l], ssm_b_re[l], ssm_b_im[l],
                           ssm_c_re[l], ssm_c_im[l], ssm_d[l], w_glu[l],
                           w_attn_up[l], w_ssm_up[l], w_out[l])
        x = layer_norm(DEEPNORM_ALPHA * x + mix, ln1_g[l], ln1_b[l])
        h = jnp.square(jax.nn.relu(x @ w_mlp_up[l])) @ w_mlp_down[l]
        x = layer_norm(DEEPNORM_ALPHA * x + h, ln2_g[l], ln2_b[l])
    return x
```

```cpp
#include <hip/hip_runtime.h>
#include <cstdio>
#include <cstdint>
__device__ __forceinline__ int opaque_tid() { int t = threadIdx.x; asm volatile("" : "+v"(t)); return t; }
namespace pg8 {
#define PG8_LAS __attribute__((address_space(3)))
typedef unsigned short bf16_t;
typedef short bf16x8 __attribute__((ext_vector_type(8)));
typedef float f32x4 __attribute__((ext_vector_type(4)));
typedef unsigned u32x4 __attribute__((ext_vector_type(4)));
constexpr int BM = 256, BK = 64, HALF = 128, HTB = HALF * BK * 2  , STAGE_BYTES = 8 * HTB, NXCD = 8, WGM = 8;

__host__ __device__ __forceinline__ int lds_byte(int r, int c) { const int st = (r >> 4) * 2 + (c >> 5), rr = r & 15, cc = c & 31, ob = rr * 64 + cc * 2; return st * 1024 + (ob ^ (((ob >> 9) & 1) << 5)); }
__host__ __device__ __forceinline__ void stage_rc(int b, int& R, int& C) { const int st = b / 1024, sb = b % 1024, swz = sb ^ (((sb >> 9) & 1) << 5); R = (st >> 1) * 16 + swz / 64; C = (st & 1) * 32 + (swz % 64) / 2; }
__host__ __device__ __forceinline__ int perm32(int rho) { const int n = rho >> 4, i = rho & 15; return 8 * (i >> 2) + 4 * n + (i & 3); }

struct Unit { int pm, pn; };
struct Gemm { const bf16_t* A; const bf16_t* Bt; int M, N, K; };

struct StaticOrder {
    int nM, nN, nwg, G, c;
    __host__ __device__ void init(int M, int N, int G_, int c_) { nM = M / BM; nN = N / BM; nwg = nM * nN; G = G_; c = c_; }
    __host__ __device__ bool next(int i, Unit& u) const {
        const long L = (long)i * G + c; if (L >= nwg) return false;
        int wgid = (int)L; { const int q = nwg / NXCD, r = nwg % NXCD, xcd = wgid % NXCD, off = wgid / NXCD; wgid = (xcd < r ? xcd * (q + 1) : r * (q + 1) + (xcd - r) * q) + off; }
        const int nig = WGM * nN, gid = wgid / nig, fm = gid * WGM, gsz = (nM - fm) < WGM ? (nM - fm) : WGM;
        u.pm = fm + ((wgid % nig) % gsz); u.pn = (wgid % nig) / gsz; return true;
    }
    __device__ __forceinline__ void a_ready(const Unit&) const {}
    __device__ __forceinline__ void done(const Unit&) const {}
};

__device__ __forceinline__ unsigned cvt_pk_bf16(float lo, float hi) { unsigned r; asm volatile("v_cvt_pk_bf16_f32 %0, %1, %2" : "=v"(r) : "v"(lo), "v"(hi)); return r; }
typedef float f32x2 __attribute__((ext_vector_type(2)));
constexpr int EPI_M = 32768;
constexpr float EPI_C2 = 0.125f * 1.4426950408889634f;
__device__ __forceinline__ float sigm(float x) { return __builtin_amdgcn_rcpf(1.0f + __builtin_amdgcn_exp2f(-1.4426950408889634f * x)); }
__device__ __forceinline__ float bf_lo(unsigned u) { return __uint_as_float(u << 16); }
__device__ __forceinline__ float bf_hi(unsigned u) { return __uint_as_float(u & 0xffff0000u); }
__device__ __forceinline__ u32x4 pack8(const f32x4 a, const f32x4 b) { u32x4 w; w.x = cvt_pk_bf16(a[0], a[1]); w.y = cvt_pk_bf16(a[2], a[3]); w.z = cvt_pk_bf16(b[0], b[1]); w.w = cvt_pk_bf16(b[2], b[3]); return w; }

typedef __amdgpu_buffer_rsrc_t brsrc;
__device__ __forceinline__ brsrc mk_rsrc(const void* p, unsigned bytes) { return __builtin_amdgcn_make_buffer_rsrc(const_cast<void*>(p), 0, bytes, 0x00020000); }
__device__ __forceinline__ u32x4 bld16(brsrc r, unsigned voff, unsigned soff) { return __builtin_amdgcn_raw_buffer_load_b128(r, voff, soff, 0); }
__device__ __forceinline__ f32x4 bld16f(brsrc r, unsigned voff, unsigned soff) { return __builtin_bit_cast(f32x4, __builtin_amdgcn_raw_buffer_load_b128(r, voff, soff, 0)); }
__device__ __forceinline__ void bst16(brsrc r, unsigned voff, unsigned soff, u32x4 v) { __builtin_amdgcn_raw_buffer_store_b128(v, r, voff + soff, 0, 0); }
__device__ __forceinline__ void bst16f(brsrc r, unsigned voff, unsigned soff, f32x4 v) { __builtin_amdgcn_raw_buffer_store_b128(__builtin_bit_cast(u32x4, v), r, voff + soff, 0, 0); }
constexpr unsigned SZ_QKV = (unsigned)EPI_M * 1024u * 2u, SZ_G = (unsigned)EPI_M * 2048u * 2u, SZ_ROPE = (unsigned)EPI_M * 32u * 4u, SZ_X = (unsigned)EPI_M * 2048u * 4u, SZ_H = (unsigned)EPI_M * 8192u * 2u;

struct EpiInProj {
    static constexpr bool PERM = true, AFTER_DRAIN = false; static constexpr int MIDK = 0;
    bf16_t *Q, *Kb, *V, *U, *GA, *GS; const float* ropeC; const float* ropeS;
    __device__ __forceinline__ void mid(f32x4 (&)[2][2][4][2], const Unit&, int, int, int, int) const {}
    __device__ __forceinline__ void operator()(const f32x4 (&acc)[2][2][4][2], const Unit& u, int wr, int wc, int fr, int fq) const {
        const int pn = u.pn; const unsigned urow = (unsigned)(u.pm * BM + wr * 64);
        if (pn < 8) {
            const brsrc rb = mk_rsrc(pn < 4 ? Q : Kb, SZ_QKV), rc = mk_rsrc(ropeC, SZ_ROPE), rs = mk_rsrc(ropeS, SZ_ROPE); const float sc = pn < 4 ? EPI_C2 : 1.0f;
            const unsigned so = (urow * 1024u + (unsigned)((pn & 3) * BM + wc * 32)) * 2u, sr = (urow * 32u + 16u * (unsigned)(wc & 1)) * 4u;
            const unsigned lo = (unsigned)(fr * 1024 + 8 * fq) * 2u, lr = (unsigned)(fr * 32 + 4 * fq) * 4u;
#pragma unroll
            for (int ai = 0; ai < 2; ++ai)
#pragma unroll
                for (int m = 0; m < 4; ++m) { const unsigned dr = (unsigned)(ai * HALF + m * 16);
                    const f32x4 cs = bld16f(rc, lr, sr + dr * 128u), sn = bld16f(rs, lr, sr + dr * 128u);
#pragma unroll
                    for (int bj = 0; bj < 2; ++bj) { const f32x4 v0 = acc[ai][bj][m][0], v1 = acc[ai][bj][m][1]; f32x4 o0, o1;
                        o0[0] = (v0[0] * cs[0] - v0[1] * sn[0]) * sc; o0[1] = (v0[1] * cs[0] + v0[0] * sn[0]) * sc;
                        o0[2] = (v0[2] * cs[1] - v0[3] * sn[1]) * sc; o0[3] = (v0[3] * cs[1] + v0[2] * sn[1]) * sc;
                        o1[0] = (v1[0] * cs[2] - v1[1] * sn[2]) * sc; o1[1] = (v1[1] * cs[2] + v1[0] * sn[2]) * sc;
                        o1[2] = (v1[2] * cs[3] - v1[3] * sn[3]) * sc; o1[3] = (v1[3] * cs[3] + v1[2] * sn[3]) * sc;
                        bst16(rb, lo, so + (dr * 1024u + (unsigned)(bj * HALF)) * 2u, pack8(o0, o1)); }
                    if (m & 1) asm volatile("" ::: "memory"); }
        } else if (pn < 12) {
            const brsrc rb = mk_rsrc(V, SZ_QKV); const unsigned so = (urow * 1024u + (unsigned)((pn - 8) * BM + wc * 32)) * 2u, lo = (unsigned)(fr * 1024 + 8 * fq) * 2u;
#pragma unroll
            for (int ai = 0; ai < 2; ++ai)
#pragma unroll
                for (int m = 0; m < 4; ++m)
#pragma unroll
                    for (int bj = 0; bj < 2; ++bj) bst16(rb, lo, so + ((unsigned)(ai * HALF + m * 16) * 1024u + (unsigned)(bj * HALF)) * 2u, pack8(acc[ai][bj][m][0], acc[ai][bj][m][1]));
        } else if (pn < 16) {
            const brsrc rb = mk_rsrc(U, SZ_QKV); const unsigned ug = (unsigned)((pn - 12) * 16 + wc * 2), so = (ug * (unsigned)EPI_M + urow) * 32u;
            const unsigned lo = (unsigned)(((fq >> 1) * EPI_M + fr) * 16 + 8 * (fq & 1)) * 2u;
#pragma unroll
            for (int ai = 0; ai < 2; ++ai)
#pragma unroll
                for (int m = 0; m < 4; ++m)
#pragma unroll
                    for (int bj = 0; bj < 2; ++bj) bst16(rb, lo, so + ((unsigned)(8 * bj) * (unsigned)EPI_M + (unsigned)(ai * HALF + m * 16)) * 32u, pack8(acc[ai][bj][m][0], acc[ai][bj][m][1]));
        } else {
            const brsrc rb = mk_rsrc(pn < 24 ? GA : GS, SZ_G); const unsigned so = (urow * 2048u + (unsigned)(((pn - 16) & 7) * BM + wc * 32)) * 2u, lo = (unsigned)(fr * 2048 + 8 * fq) * 2u;
#pragma unroll
            for (int ai = 0; ai < 2; ++ai)
#pragma unroll
                for (int m = 0; m < 4; ++m)
#pragma unroll
                    for (int bj = 0; bj < 2; ++bj) { f32x4 v0 = acc[ai][bj][m][0], v1 = acc[ai][bj][m][1];
#pragma unroll
                        for (int e = 0; e < 4; ++e) { v0[e] = sigm(v0[e]); v1[e] = sigm(v1[e]); }
                        bst16(rb, lo, so + ((unsigned)(ai * HALF + m * 16) * 2048u + (unsigned)(bj * HALF)) * 2u, pack8(v0, v1)); }
        }
    }
};

struct EpiGlu {
    static constexpr bool PERM = true, AFTER_DRAIN = false; static constexpr int MIDK = 0;
    const bf16_t* G; bf16_t* AS;
    __device__ __forceinline__ void mid(f32x4 (&)[2][2][4][2], const Unit&, int, int, int, int) const {}
    __device__ __forceinline__ void operator()(const f32x4 (&acc)[2][2][4][2], const Unit& u, int wr, int wc, int fr, int fq) const {
        const unsigned urow = (unsigned)(u.pm * BM + wr * 64), ucol = (unsigned)(u.pn * BM + wc * 32);
        const brsrc rg = mk_rsrc(G, SZ_QKV), ro = mk_rsrc(AS, SZ_G);
        const unsigned sg = (urow * 1024u + ucol) * 2u, so = (urow * 2048u + 1024u + ucol) * 2u, lg = (unsigned)(fr * 1024 + 8 * fq) * 2u, lo = (unsigned)(fr * 2048 + 8 * fq) * 2u;
#pragma unroll
        for (int ai = 0; ai < 2; ++ai)
#pragma unroll
            for (int m = 0; m < 4; ++m) { const unsigned dr = (unsigned)(ai * HALF + m * 16);
#pragma unroll
                for (int bj = 0; bj < 2; ++bj) { const u32x4 gw = bld16(rg, lg, sg + (dr * 1024u + (unsigned)(bj * HALF)) * 2u);
                    f32x4 v0 = acc[ai][bj][m][0], v1 = acc[ai][bj][m][1];
                    v0[0] = bf_lo(gw.x) * sigm(v0[0]); v0[1] = bf_hi(gw.x) * sigm(v0[1]); v0[2] = bf_lo(gw.y) * sigm(v0[2]); v0[3] = bf_hi(gw.y) * sigm(v0[3]);
                    v1[0] = bf_lo(gw.z) * sigm(v1[0]); v1[1] = bf_hi(gw.z) * sigm(v1[1]); v1[2] = bf_lo(gw.w) * sigm(v1[2]); v1[3] = bf_hi(gw.w) * sigm(v1[3]);
                    bst16(ro, lo, so + (dr * 2048u + (unsigned)(bj * HALF)) * 2u, pack8(v0, v1)); }
                if (m & 1) asm volatile("" ::: "memory"); }
    }
};

struct EpiMerge {
    static constexpr bool PERM = true, AFTER_DRAIN = false; static constexpr int MIDK = 16;
    bf16_t* GA; const bf16_t* GS;
    __device__ __forceinline__ void mid(f32x4 (&acc)[2][2][4][2], const Unit& u, int wr, int wc, int fr, int fq) const {
        const brsrc ra = mk_rsrc(GA, SZ_G), rs = mk_rsrc(GS, SZ_G);
        const unsigned so = ((unsigned)(u.pm * BM + wr * 64) * 2048u + (unsigned)(u.pn * BM + wc * 32)) * 2u, lo = (unsigned)(fr * 2048 + 8 * fq) * 2u;
#pragma unroll
        for (int ai = 0; ai < 2; ++ai)
#pragma unroll
            for (int m = 0; m < 4; ++m) {
#pragma unroll
                for (int bj = 0; bj < 2; ++bj) { const unsigned o = so + ((unsigned)(ai * HALF + m * 16) * 2048u + (unsigned)(bj * HALF)) * 2u; const u32x4 a = bld16(ra, lo, o), s = bld16(rs, lo, o);
                    f32x4& v0 = acc[ai][bj][m][0]; f32x4& v1 = acc[ai][bj][m][1];
                    v0[0] *= bf_lo(a.x) * __builtin_amdgcn_rcpf(fmaxf(bf_lo(s.x), 1e-20f)); v0[1] *= bf_hi(a.x) * __builtin_amdgcn_rcpf(fmaxf(bf_hi(s.x), 1e-20f));
                    v0[2] *= bf_lo(a.y) * __builtin_amdgcn_rcpf(fmaxf(bf_lo(s.y), 1e-20f)); v0[3] *= bf_hi(a.y) * __builtin_amdgcn_rcpf(fmaxf(bf_hi(s.y), 1e-20f));
                    v1[0] *= bf_lo(a.z) * __builtin_amdgcn_rcpf(fmaxf(bf_lo(s.z), 1e-20f)); v1[1] *= bf_hi(a.z) * __builtin_amdgcn_rcpf(fmaxf(bf_hi(s.z), 1e-20f));
                    v1[2] *= bf_lo(a.w) * __builtin_amdgcn_rcpf(fmaxf(bf_lo(s.w), 1e-20f)); v1[3] *= bf_hi(a.w) * __builtin_amdgcn_rcpf(fmaxf(bf_hi(s.w), 1e-20f)); }
                if (m & 1) asm volatile("" ::: "memory"); }
    }
    __device__ __forceinline__ void operator()(const f32x4 (&acc)[2][2][4][2], const Unit& u, int wr, int wc, int fr, int fq) const {
        const brsrc ra = mk_rsrc(GA, SZ_G), rs = mk_rsrc(GS, SZ_G);
        const unsigned so = ((unsigned)(u.pm * BM + wr * 64) * 2048u + (unsigned)(u.pn * BM + wc * 32)) * 2u, lo = (unsigned)(fr * 2048 + 8 * fq) * 2u;
#pragma unroll
        for (int ai = 0; ai < 2; ++ai)
#pragma unroll
            for (int m = 0; m < 4; ++m) {
#pragma unroll
                for (int bj = 0; bj < 2; ++bj) { const unsigned o = so + ((unsigned)(ai * HALF + m * 16) * 2048u + (unsigned)(bj * HALF)) * 2u; const u32x4 s = bld16(rs, lo, o);
                    f32x4 v0 = acc[ai][bj][m][0], v1 = acc[ai][bj][m][1];
                    v0[0] *= fmaxf(bf_lo(s.x), 1e-20f); v0[1] *= fmaxf(bf_hi(s.x), 1e-20f); v0[2] *= fmaxf(bf_lo(s.y), 1e-20f); v0[3] *= fmaxf(bf_hi(s.y), 1e-20f);
                    v1[0] *= fmaxf(bf_lo(s.z), 1e-20f); v1[1] *= fmaxf(bf_hi(s.z), 1e-20f); v1[2] *= fmaxf(bf_lo(s.w), 1e-20f); v1[3] *= fmaxf(bf_hi(s.w), 1e-20f);
                    bst16(ra, lo, o, pack8(v0, v1)); }
                if (m & 1) asm volatile("" ::: "memory"); }
    }
};

struct EpiResF32 {
    static constexpr bool PERM = false, AFTER_DRAIN = false; static constexpr int MIDK = 0;
    const float* xin; float* out; float alpha;
    __device__ __forceinline__ void mid(f32x4 (&)[2][2][4][2], const Unit&, int, int, int, int) const {}
    __device__ __forceinline__ void operator()(const f32x4 (&acc)[2][2][4][2], const Unit& u, int wr, int wc, int fr, int fq) const {
        const brsrc ri = mk_rsrc(xin, SZ_X), ro = mk_rsrc(out, SZ_X);
        const unsigned so = ((unsigned)(u.pm * BM + wr * 64) * 2048u + (unsigned)(u.pn * BM + wc * 32)) * 4u, lo = (unsigned)(fr * 2048 + 4 * fq) * 4u;
#pragma unroll
        for (int ai = 0; ai < 2; ++ai)
#pragma unroll
            for (int m = 0; m < 4; ++m) {
#pragma unroll
                for (int bj = 0; bj < 2; ++bj)
#pragma unroll
                    for (int n = 0; n < 2; ++n) { const unsigned o = so + ((unsigned)(ai * HALF + m * 16) * 2048u + (unsigned)(bj * HALF + n * 16)) * 4u; const f32x4 xv = bld16f(ri, lo, o); bst16f(ro, lo, o, xv * alpha + acc[ai][bj][m][n]); }
                if (m & 1) asm volatile("" ::: "memory"); }
    }
};

struct EpiRelu2 {
    static constexpr bool PERM = true, AFTER_DRAIN = false; static constexpr int MIDK = 0;
    bf16_t* H;
    __device__ __forceinline__ void mid(f32x4 (&)[2][2][4][2], const Unit&, int, int, int, int) const {}
    __device__ __forceinline__ void operator()(const f32x4 (&acc)[2][2][4][2], const Unit& u, int wr, int wc, int fr, int fq) const {
        const brsrc rb = mk_rsrc(H, SZ_H); const unsigned so = ((unsigned)(u.pm * BM + wr * 64) * 8192u + (unsigned)(u.pn * BM + wc * 32)) * 2u, lo = (unsigned)(fr * 8192 + 8 * fq) * 2u;
#pragma unroll
        for (int ai = 0; ai < 2; ++ai)
#pragma unroll
            for (int m = 0; m < 4; ++m)
#pragma unroll
                for (int bj = 0; bj < 2; ++bj) { f32x4 v0 = acc[ai][bj][m][0], v1 = acc[ai][bj][m][1];
#pragma unroll
                    for (int e = 0; e < 4; ++e) { const float a = fmaxf(v0[e], 0.f), b = fmaxf(v1[e], 0.f); v0[e] = a * a; v1[e] = b * b; }
                    bst16(rb, lo, so + ((unsigned)(ai * HALF + m * 16) * 8192u + (unsigned)(bj * HALF)) * 2u, pack8(v0, v1)); }
    }
};
template <class Epi, class Sched, bool ALIGN_EPI = false, bool SP2 = false, bool DRAINALL = false>
__device__ __forceinline__ void gemm_phase(PG8_LAS unsigned char* lds, const Gemm g, const Sched& S, const Epi& E) {
    const int tid = opaque_tid(), wid = __builtin_amdgcn_readfirstlane(tid >> 6), lane = tid & 63, wr = wid >> 2, wc = wid & 3, fr = lane & 15, fq = lane >> 4;
    const int K = g.K, nt = K / BK;
    unsigned voffA[2], voffB[2];
#pragma unroll
    for (int i = 0; i < 2; ++i) { int R, C; stage_rc(tid * 16 + i * 8192, R, C); const int Rb = Epi::PERM ? ((R & ~31) + perm32(R & 31)) : R;
        voffA[i] = (unsigned)(R * K + C) * 2u; voffB[i] = (unsigned)(Rb * K + C) * 2u; }
    const size_t kstep = (size_t)(BK * 2);
    const size_t hstep = (size_t)HALF * K * 2;
    const size_t tstep = 2 * hstep;
    const unsigned ldsw = (unsigned)wid * 1024u;
    const int aoff = lds_byte(wr * 64 + fr, fq * 8), boff = lds_byte(wc * 32 + fr, fq * 8);
#define PG8_SA(b, h) (((b) * 2 + (h)) * HTB)
#define PG8_SB(b, h) ((4 + (b) * 2 + (h)) * HTB)
#define PG8_STAGE(bufoff, gbase, voff) do { _Pragma("unroll") for (int _i = 0; _i < 2; ++_i) \
        __builtin_amdgcn_global_load_lds((const unsigned*)((const char*)(gbase) + (voff)[_i]), (PG8_LAS unsigned*)(lds + (bufoff) + ldsw + _i * 8192), 16, 0, 0); } while (0)
#define PG8_LDA(dst, b, h) do { _Pragma("unroll") for (int m = 0; m < 4; ++m) _Pragma("unroll") for (int k = 0; k < 2; ++k) dst[m][k] = *(const PG8_LAS bf16x8*)(lds + PG8_SA(b, h) + aoff + m * 2048 + k * 1024); } while (0)
#define PG8_LDB(dst, b, h) do { _Pragma("unroll") for (int n = 0; n < 2; ++n) _Pragma("unroll") for (int k = 0; k < 2; ++k) dst[n][k] = *(const PG8_LAS bf16x8*)(lds + PG8_SB(b, h) + boff + n * 2048 + k * 1024); } while (0)
#define PG8_MMA(ai, bj, At, Bt) do { __builtin_amdgcn_s_setprio(1); _Pragma("unroll") for (int m = 0; m < 4; ++m) _Pragma("unroll") for (int n = 0; n < 2; ++n) _Pragma("unroll") for (int k = 0; k < 2; ++k) \
        acc[ai][bj][m][n] = __builtin_amdgcn_mfma_f32_16x16x32_bf16(Bt[n][k], At[m][k], acc[ai][bj][m][n], 0, 0, 0); __builtin_amdgcn_s_setprio(0); } while (0)
#define PG8_WAIT_V(n) do { if constexpr (DRAINALL) asm volatile("s_waitcnt vmcnt(0)" ::: "memory"); else asm volatile("s_waitcnt vmcnt(" #n ")" ::: "memory"); } while (0)
#define PG8_WAIT_L(n) asm volatile("s_waitcnt lgkmcnt(" #n ")" ::: "memory")
#define PG8_BAR __builtin_amdgcn_s_barrier()
#define PG8_SCHED __builtin_amdgcn_sched_barrier(0)
    Unit cur, nxt; int ui = 0;
    if (!S.next(0, cur)) return;
    f32x4 acc[2][2][4][2];
#pragma unroll
    for (int a = 0; a < 2; ++a)
#pragma unroll
        for (int b = 0; b < 2; ++b)
#pragma unroll
            for (int m = 0; m < 4; ++m)
#pragma unroll
                for (int n = 0; n < 2; ++n) acc[a][b][m][n] = (f32x4){0.f, 0.f, 0.f, 0.f};
    bf16x8 At[4][2], B0[2][2], B1[2][2];
    const char* cA = (const char*)g.A + (size_t)cur.pm * tstep; const char* cB = (const char*)g.Bt + (size_t)cur.pn * tstep;
    S.a_ready(cur);
    if constexpr (SP2) {
        PG8_STAGE(PG8_SB(0, 0), cB, voffB); PG8_STAGE(PG8_SB(0, 1), cB + hstep, voffB); PG8_STAGE(PG8_SA(0, 0), cA, voffA); PG8_STAGE(PG8_SA(0, 1), cA + hstep, voffA);
        if (wr == 1) PG8_BAR;
        PG8_WAIT_V(2); PG8_BAR;
        PG8_STAGE(PG8_SB(1, 0), cB + kstep, voffB); PG8_STAGE(PG8_SA(1, 0), cA + kstep, voffA); PG8_STAGE(PG8_SB(1, 1), cB + hstep + kstep, voffB);
        PG8_WAIT_V(6); PG8_BAR;
    } else {
        PG8_STAGE(PG8_SB(0, 0), cB, voffB); PG8_STAGE(PG8_SA(0, 0), cA, voffA); PG8_STAGE(PG8_SB(0, 1), cB + hstep, voffB); PG8_STAGE(PG8_SA(0, 1), cA + hstep, voffA);
        if (wr == 1) PG8_BAR;
        PG8_WAIT_V(4); PG8_BAR;
        PG8_STAGE(PG8_SB(1, 0), cB + kstep, voffB); PG8_STAGE(PG8_SA(1, 0), cA + kstep, voffA); PG8_STAGE(PG8_SB(1, 1), cB + hstep + kstep, voffB);
        PG8_WAIT_V(6); PG8_BAR;
    }
    for (;;) {
        const bool has_next = S.next(ui + 1, nxt);
        const char* nA = has_next ? (const char*)g.A + (size_t)nxt.pm * tstep : cA; const char* nB = has_next ? (const char*)g.Bt + (size_t)nxt.pn * tstep : cB;
        for (int t = 0; t < nt; t += 2) {
            const bool last = (t == nt - 2);
            const char* a1 = cA + (size_t)(t + 1) * kstep;
            const char* a2 = last ? nA : cA + (size_t)(t + 2) * kstep; const char* b2 = last ? nB : cB + (size_t)(t + 2) * kstep;
            const char* a3 = a2 + kstep; const char* b3 = b2 + kstep;
            if (last && has_next) S.a_ready(nxt);
            if constexpr (SP2) {
            PG8_LDB(B0, 0, 0); PG8_LDB(B1, 0, 1); PG8_SCHED; PG8_LDA(At, 0, 0); PG8_STAGE(PG8_SA(1, 1), a1 + hstep, voffA);
            PG8_WAIT_V(8); PG8_WAIT_L(0); PG8_BAR; PG8_MMA(0, 0, At, B0); PG8_MMA(0, 1, At, B1); PG8_BAR; PG8_SCHED;
            PG8_LDA(At, 0, 1); PG8_STAGE(PG8_SB(0, 0), b2, voffB); PG8_STAGE(PG8_SB(0, 1), b2 + hstep, voffB); PG8_STAGE(PG8_SA(0, 0), a2, voffA);
            PG8_WAIT_V(8); PG8_WAIT_L(0); PG8_BAR; PG8_MMA(1, 0, At, B0); PG8_MMA(1, 1, At, B1); PG8_BAR; PG8_SCHED;
            PG8_LDB(B0, 1, 0); PG8_LDB(B1, 1, 1); PG8_SCHED; PG8_LDA(At, 1, 0); PG8_STAGE(PG8_SA(0, 1), a2 + hstep, voffA);
            PG8_WAIT_V(8); PG8_WAIT_L(0); PG8_BAR; PG8_MMA(0, 0, At, B0); PG8_MMA(0, 1, At, B1); PG8_BAR; PG8_SCHED;
            PG8_LDA(At, 1, 1); PG8_STAGE(PG8_SB(1, 0), b3, voffB); PG8_STAGE(PG8_SB(1, 1), b3 + hstep, voffB); PG8_STAGE(PG8_SA(1, 0), a3, voffA);
            PG8_WAIT_V(8); PG8_WAIT_L(0); PG8_BAR; PG8_MMA(1, 0, At, B0); PG8_MMA(1, 1, At, B1); PG8_BAR; PG8_SCHED;
            } else {
            PG8_LDB(B0, 0, 0); PG8_SCHED; PG8_LDA(At, 0, 0); PG8_STAGE(PG8_SA(1, 1), a1 + hstep, voffA);
            PG8_WAIT_L(8); PG8_BAR; PG8_WAIT_L(0); PG8_MMA(0, 0, At, B0); PG8_BAR; PG8_SCHED;
            PG8_LDB(B1, 0, 1); PG8_STAGE(PG8_SB(0, 0), b2, voffB);
            PG8_BAR; PG8_WAIT_L(0); PG8_MMA(0, 1, At, B1); PG8_BAR;
            PG8_LDA(At, 0, 1); PG8_STAGE(PG8_SA(0, 0), a2, voffA);
            PG8_BAR; PG8_WAIT_L(0); PG8_MMA(1, 0, At, B0); PG8_BAR; PG8_SCHED;
            PG8_STAGE(PG8_SB(0, 1), b2 + hstep, voffB);
            PG8_WAIT_V(6); PG8_BAR; PG8_MMA(1, 1, At, B1); PG8_BAR;
            PG8_LDB(B0, 1, 0); PG8_SCHED; PG8_LDA(At, 1, 0); PG8_STAGE(PG8_SA(0, 1), a2 + hstep, voffA);
            PG8_WAIT_L(8); PG8_BAR; PG8_WAIT_L(0); PG8_MMA(0, 0, At, B0); PG8_BAR; PG8_SCHED;
            PG8_LDB(B1, 1, 1); PG8_STAGE(PG8_SB(1, 0), b3, voffB);
            PG8_BAR; PG8_WAIT_L(0); PG8_MMA(0, 1, At, B1); PG8_BAR;
            PG8_LDA(At, 1, 1); PG8_STAGE(PG8_SA(1, 0), a3, voffA);
            PG8_BAR; PG8_WAIT_L(0); PG8_MMA(1, 0, At, B0); PG8_BAR; PG8_SCHED;
            PG8_STAGE(PG8_SB(1, 1), b3 + hstep, voffB);
            PG8_WAIT_V(6); PG8_BAR; PG8_MMA(1, 1, At, B1); PG8_BAR;
            }
            if constexpr (Epi::MIDK > 0) { if (t + 2 == Epi::MIDK) E.mid(acc, cur, wr, wc, fr, fq); }
        }
        if constexpr (ALIGN_EPI) { if (wr == 0) PG8_BAR; }
        if constexpr (!Epi::AFTER_DRAIN) { E(acc, cur, wr, wc, fr, fq); S.done(cur); }
        if (!has_next) break;
#pragma unroll
        for (int a = 0; a < 2; ++a)
#pragma unroll
            for (int b = 0; b < 2; ++b)
#pragma unroll
                for (int m = 0; m < 4; ++m)
#pragma unroll
                    for (int n = 0; n < 2; ++n) acc[a][b][m][n] = (f32x4){0.f, 0.f, 0.f, 0.f};
        cur = nxt; cA = nA; cB = nB; ++ui;
        if constexpr (ALIGN_EPI) { if (wr == 1) PG8_BAR; }
    }
    PG8_WAIT_V(0);
    if constexpr (!ALIGN_EPI) { if (wr == 0) PG8_BAR; }
    PG8_BAR;
    if constexpr (Epi::AFTER_DRAIN) { E.fused(acc, cur, wr, wc, fr, fq, lds, wid, lane); S.done(cur); }
#undef PG8_SA
#undef PG8_SB
#undef PG8_STAGE
#undef PG8_LDA
#undef PG8_LDB
#undef PG8_MMA
#undef PG8_WAIT_V
#undef PG8_WAIT_L
#undef PG8_BAR
#undef PG8_SCHED
}
}
#include <hip/hip_bf16.h>
#include <cmath>
namespace attn_body {
using bf16=__hip_bfloat16;
using bf16x8=__attribute__((ext_vector_type(8)))short;
using s16x4=__attribute__((ext_vector_type(4)))short;
using f32x16=__attribute__((ext_vector_type(16)))float;
using u32x4=__attribute__((ext_vector_type(4)))unsigned;
constexpr int SEQ=8192,D=64,DM=1024,OPITCH=2048;
constexpr int NW=8,QBLK=32,QB=QBLK*NW,KVBLK=64,NQB=SEQ/QB;
constexpr int ATTN_UNIT_ROWS=QB;
__device__ __forceinline__ int crow(int r,int hi){return (r&3)+8*(r>>2)+4*hi;}
#define SBAR() __builtin_amdgcn_sched_barrier(0)
__device__ __forceinline__ void cmask(f32x16&p0,f32x16&p1,int jb,int qrel,int hi){
  const float NEG=-INFINITY; int kb=64*jb+4*hi;
  #pragma unroll
  for(int r=0;r<16;++r){int kv=kb+(r&3)+8*(r>>2); if(kv>qrel)p0[r]=NEG; if(kv+32>qrel)p1[r]=NEG;}
}

constexpr int NSLOT=3, SLOTB=8192;
constexpr int LDS_K=0, LDS_V=NSLOT*SLOTB, LDS_WS=2*NSLOT*SLOTB, LDS_OST=LDS_WS+NW*64*4, LDS_BYTES=LDS_OST+NW*4096;
constexpr float C2=0.125f*1.4426950408889634f;
__device__ __forceinline__ void glds16(const void*gsrc,unsigned lds_dst){unsigned keep;
  asm volatile("s_mov_b32 %0, m0\n\ts_mov_b32 m0, %2\n\ts_nop 0\n\tglobal_load_lds_dwordx4 %1, off\n\ts_mov_b32 m0, %0":"=&s"(keep):"v"(gsrc),"s"(lds_dst):"memory");}
__device__ __forceinline__ float max3f(float a,float b,float c){float r;asm("v_max3_f32 %0, %1, %2, %3":"=v"(r):"v"(a),"v"(b),"v"(c));return r;}
__device__ __forceinline__ float max2f(float a,float b){float r;asm("v_max_f32_e32 %0, %1, %2":"=v"(r):"v"(a),"v"(b));return r;}
__device__ __forceinline__ float fadd_s(float a,float b){float r;asm("v_add_f32_e32 %0, %1, %2":"=v"(r):"v"(a),"v"(b));return r;}
__device__ __forceinline__ float fsub_s(float a,float b){float r;asm("v_sub_f32_e32 %0, %1, %2":"=v"(r):"v"(a),"v"(b));return r;}
typedef float f32x2_t __attribute__((ext_vector_type(2))); typedef __bf16 bf16x2_t __attribute__((ext_vector_type(2)));
__device__ __forceinline__ unsigned cvtpk_s(float lo,float hi){f32x2_t v={lo,hi};bf16x2_t b=__builtin_convertvector(v,bf16x2_t);return __builtin_bit_cast(unsigned,b);}
#define WAIT_BAR(N) asm volatile("s_waitcnt vmcnt(" #N ") lgkmcnt(0)\n\ts_barrier":::"memory")

__device__ __forceinline__ void qkt(f32x16&p0,f32x16&p1,const char*Kslot,const bf16x8*qr,const f32x16&negm,int r32,int hi){
  const char*kb=Kslot+hi*1024+r32*16;
  #pragma unroll
  for(int d0=0;d0<4;++d0){
    const bf16x8 b0=*reinterpret_cast<const bf16x8*>(kb+d0*2048);
    const bf16x8 b1=*reinterpret_cast<const bf16x8*>(kb+d0*2048+512);
    if(d0==0){p0=__builtin_amdgcn_mfma_f32_32x32x16_bf16(b0,qr[0],negm,0,0,0);p1=__builtin_amdgcn_mfma_f32_32x32x16_bf16(b1,qr[0],negm,0,0,0);}
    else{p0=__builtin_amdgcn_mfma_f32_32x32x16_bf16(b0,qr[d0],p0,0,0,0);p1=__builtin_amdgcn_mfma_f32_32x32x16_bf16(b1,qr[d0],p1,0,0,0);}}
}
typedef __attribute__((address_space(3))) const char* lds_cptr;
typedef short v4i16_t __attribute__((ext_vector_type(4)));
__device__ __forceinline__ void kload8(bf16x8*kf,lds_cptr kp){
  kf[0]=*(const __attribute__((address_space(3))) bf16x8*)(kp);      kf[1]=*(const __attribute__((address_space(3))) bf16x8*)(kp+512);
  kf[2]=*(const __attribute__((address_space(3))) bf16x8*)(kp+2048); kf[3]=*(const __attribute__((address_space(3))) bf16x8*)(kp+2560);
  kf[4]=*(const __attribute__((address_space(3))) bf16x8*)(kp+4096); kf[5]=*(const __attribute__((address_space(3))) bf16x8*)(kp+4608);
  kf[6]=*(const __attribute__((address_space(3))) bf16x8*)(kp+6144); kf[7]=*(const __attribute__((address_space(3))) bf16x8*)(kp+6656);
}
__device__ __forceinline__ void kload2(bf16x8*kf,lds_cptr kp,int j){ kf[2*j]=*(const __attribute__((address_space(3))) bf16x8*)(kp+j*2048); kf[2*j+1]=*(const __attribute__((address_space(3))) bf16x8*)(kp+j*2048+512); }
__device__ __forceinline__ s16x4 vtr(lds_cptr p){ return __builtin_bit_cast(s16x4,__builtin_amdgcn_ds_read_tr16_b64_v4i16((__attribute__((address_space(3))) v4i16_t*)p)); }
__device__ __forceinline__ float rowmax(const f32x16&p0,const f32x16&p1){
  float a=max3f(p0[0],p0[1],p1[0]),b=max3f(p0[2],p0[3],p1[1]);a=max3f(a,p1[2],p1[3]);
  #pragma unroll
  for(int r=4;r<16;r+=4){a=max3f(a,p0[r],p0[r+1]);b=max3f(b,p0[r+2],p0[r+3]);a=max3f(a,p1[r],p1[r+1]);b=max3f(b,p1[r+2],p1[r+3]);}
  const float m=max2f(a,b);
  auto rr=__builtin_amdgcn_permlane32_swap(__float_as_uint(m),__float_as_uint(m),false,false);
  return max2f(__uint_as_float(rr[0]),__uint_as_float(rr[1]));
}
__device__ __forceinline__ void pv(f32x16*o,int vb,bf16x8 pa0,bf16x8 pa1,bf16x8 pa2,bf16x8 pa3){
  #pragma unroll
  for(int d0=0;d0<2;++d0){s16x4 lo[4],hi[4];
    #pragma unroll
    for(int ks=0;ks<4;++ks){
      asm volatile("ds_read_b64_tr_b16 %0,%1 offset:%c2":"=&v"(lo[ks]):"v"(vb),"i"(d0*4096+ks*1024):"memory");
      asm volatile("ds_read_b64_tr_b16 %0,%1 offset:%c2":"=&v"(hi[ks]):"v"(vb),"i"(d0*4096+ks*1024+512):"memory");}
    asm volatile("s_waitcnt lgkmcnt(0)":::"memory");SBAR();
    #define PK(k) (bf16x8){lo[k][0],lo[k][1],lo[k][2],lo[k][3],hi[k][0],hi[k][1],hi[k][2],hi[k][3]}
    o[d0]=__builtin_amdgcn_mfma_f32_32x32x16_bf16(pa0,PK(0),o[d0],0,0,0);
    o[d0]=__builtin_amdgcn_mfma_f32_32x32x16_bf16(pa1,PK(1),o[d0],0,0,0);
    o[d0]=__builtin_amdgcn_mfma_f32_32x32x16_bf16(pa2,PK(2),o[d0],0,0,0);
    o[d0]=__builtin_amdgcn_mfma_f32_32x32x16_bf16(pa3,PK(3),o[d0],0,0,0);
    #undef PK
  }
}

#ifndef ATTN_STORE16
#define ATTN_STORE16(p,v) (*(u32x4*)(p)=(v))
#endif
template<int THRL> __device__ __forceinline__ void attn_unit(int b,int qcol,int vcol,int ocol,int qb,const bf16*Q,const bf16*__restrict__ K,const bf16*__restrict__ V,bf16*O,char*shm){
  const int tid=opaque_tid(),lane=tid&63,r32=lane&31,hi=lane>>5; const int wid=__builtin_amdgcn_readfirstlane(tid>>6);
  const long rowbase=(long)b*SEQ; const int q0=qb*QB;
  const bf16*Qw=Q+(rowbase+q0+wid*QBLK)*DM+qcol;
  const bf16*Kh=K+rowbase*DM+qcol,*Vh=V+rowbase*DM+vcol;
  const unsigned lds0=(unsigned)(uintptr_t)shm;
  float*wsf=(float*)(shm+LDS_WS)+wid*64;
  const bf16*ksrc=Kh+(long)lane*DM+wid*8;
  const bf16*vsrc=Vh+(long)(16*(wid&3)+(lane>>2))*DM+(wid>>2)*32+(lane&3)*8;
  const unsigned kdst=lds0+LDS_K+wid*1024, vdst=lds0+LDS_V+wid*1024;
  #define DMA_K(t,slot) glds16(ksrc+(long)(t)*KVBLK*DM,(unsigned)__builtin_amdgcn_readfirstlane(kdst+(slot)))
  #define DMA_V(t,slot) glds16(vsrc+(long)(t)*KVBLK*DM,(unsigned)__builtin_amdgcn_readfirstlane(vdst+(slot)))
  const int vb0=(int)(lds0+LDS_V)+((lane>>4)&1)*32+(lane&3)*8+(4*hi+((lane&15)>>2))*64;
  const char*Kbase=shm+LDS_K; bf16x8 kf[8];
  const lds_cptr shm3=(lds_cptr)shm; const lds_cptr kp0=shm3+LDS_K+hi*1024+r32*16; const lds_cptr vp0=shm3+LDS_V+((lane>>4)&1)*32+(lane&3)*8+(4*hi+((lane&15)>>2))*64;
  const int NT=(q0+QB)/KVBLK;
  DMA_K(0,0);DMA_V(0,0);DMA_K(1,SLOTB);
  bf16x8 qr[4];
  #pragma unroll
  for(int d0=0;d0<4;++d0)qr[d0]=*reinterpret_cast<const bf16x8*>(&Qw[(long)r32*DM+d0*16+hi*8]);
  float mhat=0.f,l_reg=0.f;f32x16 o[2];o[0]=f32x16{};o[1]=f32x16{};f32x16 negm=f32x16{};asm volatile("":"+v"(negm));
  const int qrel=wid*QBLK+r32;
  #define CMASK(P0,P1,t) do{int jb_=(t)-(NT-4); if(jb_>=0)cmask(P0,P1,jb_,qrel,hi);}while(0)
  bool resc=false;
  #define START(P0,P1) do{ const float rm=rowmax(P0,P1); resc=false; \
    { const float dl=rm; mhat=fadd_s(mhat,dl); \
      _Pragma("unroll") for(int r=0;r<16;++r){P0[r]=fsub_s(P0[r],dl);P1[r]=fsub_s(P1[r],dl);} \
      _Pragma("unroll") for(int r=0;r<16;++r)negm[r]=-mhat; asm volatile("":"+v"(negm)); } \
    _Pragma("unroll") for(int r=0;r<16;++r)P0[r]=__builtin_amdgcn_exp2f(P0[r]); }while(0)
  #define RESC() do{ if(resc){ asm volatile("s_waitcnt lgkmcnt(0)":::"memory"); \
      _Pragma("unroll") for(int d_=0;d_<2;++d_) _Pragma("unroll") for(int r=0;r<16;++r)o[d_][r]*=wsf[crow(r,hi)]; } }while(0)
  f32x16 pA0,pA1,pB0,pB1;
  int sl_prev=0,sl_cur=0,sl_next=SLOTB;
  #define ROT() do{sl_prev=sl_cur;sl_cur=sl_next;sl_next=(sl_next==(NSLOT-1)*SLOTB)?0:sl_next+SLOTB;}while(0)
  DMA_K(2,2*SLOTB);
  WAIT_BAR(3);
  qkt(pA0,pA1,Kbase,qr,negm,r32,hi);asm volatile("s_nop 15\n\ts_nop 7":"+v"(pA0),"+v"(pA1));CMASK(pA0,pA1,0);
  START(pA0,pA1);
  _Pragma("unroll") for(int r=0;r<16;++r)pA1[r]=__builtin_amdgcn_exp2f(pA1[r]);
  WAIT_BAR(0);
  DMA_K(3,0);DMA_V(1,SLOTB);
  ROT();
  kload8(kf,kp0+sl_cur);
  WAIT_BAR(2);
  s16x4 vlo[8],vhi[8]; u32x4 pw0,pw1,pw2,pw3;
  #define PKW(P,B) cvtpk_s(P[B],P[B+1])
  #define PAF(k) __builtin_bit_cast(bf16x8,pw##k)
  #define VFR(i) (bf16x8){vlo[i][0],vlo[i][1],vlo[i][2],vlo[i][3],vhi[i][0],vhi[i][1],vhi[i][2],vhi[i][3]}
  #define PIN(x) asm volatile("":"+v"(x))
  #define MX3(a,b,c) __builtin_fmaxf(__builtin_fmaxf((a),(b)),(c))
  #define GAPA(MF,A0,A1,A2,A3,W0,W1,PW) do{ MF; sacc+=A0; sacc+=A1; sacc+=A2; sacc+=A3; PIN(sacc); W0; W1; PIN(PW); SBAR(); }while(0)
  #define EX(v) __builtin_amdgcn_exp2f(v)
  #define GAPB(MF,X,B) do{ MF; X[B]=EX(X[B]); X[B+1]=EX(X[B+1]); X[B+2]=EX(X[B+2]); X[B+3]=EX(X[B+3]); PIN(X); SBAR(); }while(0)
  #define VRD(i) do{ vlo[i]=vtr(vp_+(((i)>>2)*4096+((i)&3)*1024)); vhi[i]=vtr(vp_+(((i)>>2)*4096+((i)&3)*1024+512)); }while(0)
  #define KRD(G,j) do{ if(G){ kload2(kf,kp0+sl_next,j); SBAR(); } }while(0)
  #define STEP(C0,C1,P0,P1,t,GK,GV,GL) do{ SBAR(); \
    const lds_cptr vp_=vp0+sl_prev; \
    VRD(0); SBAR(); float sacc=(P0[0]+P0[1]); \
    GAPA(C0=__builtin_amdgcn_mfma_f32_32x32x16_bf16(kf[0],qr[0],negm,0,0,0), P0[2],P0[3],P0[4],P0[5],     pw0[0]=PKW(P0,0), pw0[1]=PKW(P0,2), pw0); \
    VRD(4); SBAR(); GAPA(C1=__builtin_amdgcn_mfma_f32_32x32x16_bf16(kf[1],qr[0],negm,0,0,0), P0[6],P0[7],P0[8],P0[9],     pw0[2]=PKW(P0,4), pw0[3]=PKW(P0,6), pw0); \
    VRD(1); SBAR(); GAPA(C0=__builtin_amdgcn_mfma_f32_32x32x16_bf16(kf[2],qr[1],C0,0,0,0),   P0[10],P0[11],P0[12],P0[13], pw1[0]=PKW(P0,8), pw1[1]=PKW(P0,10), pw1); \
    VRD(5); SBAR(); GAPA(C1=__builtin_amdgcn_mfma_f32_32x32x16_bf16(kf[3],qr[1],C1,0,0,0),   P0[14],P0[15],P1[0],P1[1],   pw1[2]=PKW(P0,12),pw1[3]=PKW(P0,14), pw1); \
    VRD(2); SBAR(); GAPA(C0=__builtin_amdgcn_mfma_f32_32x32x16_bf16(kf[4],qr[2],C0,0,0,0),   P1[2],P1[3],P1[4],P1[5],     pw2[0]=PKW(P1,0), pw2[1]=PKW(P1,2), pw2); \
    VRD(6); SBAR(); GAPA(C1=__builtin_amdgcn_mfma_f32_32x32x16_bf16(kf[5],qr[2],C1,0,0,0),   P1[6],P1[7],P1[8],P1[9],     pw2[2]=PKW(P1,4), pw2[3]=PKW(P1,6), pw2); \
    VRD(3); SBAR(); GAPA(C0=__builtin_amdgcn_mfma_f32_32x32x16_bf16(kf[6],qr[3],C0,0,0,0),   P1[10],P1[11],P1[12],P1[13], pw3[0]=PKW(P1,8), pw3[1]=PKW(P1,10), pw3); \
    VRD(7); SBAR(); GAPA(C1=__builtin_amdgcn_mfma_f32_32x32x16_bf16(kf[7],qr[3],C1,0,0,0),   P1[14],P1[15],0.f,0.f,       pw3[2]=PKW(P1,12),pw3[3]=PKW(P1,14), pw3); \
    l_reg+=sacc; \
    if(GK){DMA_K((t)+3,sl_cur);} if(GV){DMA_V((t)+1,sl_next);} \
    CMASK(C0,C1,t); \
    { float a=MX3(C0[0],C0[1],C1[0]),b=MX3(C0[2],C0[3],C1[1]); a=MX3(a,C1[2],C1[3]); \
      _Pragma("unroll") for(int r=4;r<16;r+=4){a=MX3(a,C0[r],C0[r+1]);b=MX3(b,C0[r+2],C0[r+3]);a=MX3(a,C1[r],C1[r+1]);b=MX3(b,C1[r+2],C1[r+3]);} \
      float rm=__builtin_fmaxf(a,b); { auto rr=__builtin_amdgcn_permlane32_swap(__float_as_uint(rm),__float_as_uint(rm),false,false); rm=__builtin_fmaxf(__uint_as_float(rr[0]),__uint_as_float(rr[1])); } \
      resc=false; \
      if(__builtin_expect(__any(rm>(float)THRL),0)){ const float dl=__builtin_fmaxf(rm,0.f); mhat+=dl; \
        _Pragma("unroll") for(int r=0;r<16;++r){C0[r]-=dl;C1[r]-=dl;} \
        _Pragma("unroll") for(int r=0;r<16;++r)negm[r]=-mhat; asm volatile("":"+v"(negm)); \
        const float f=__builtin_amdgcn_exp2f(-dl); l_reg*=f; if(hi==0)wsf[r32]=f; resc=true; } } \
    SBAR(); \
    GAPB(o[0]=__builtin_amdgcn_mfma_f32_32x32x16_bf16(PAF(0),VFR(0),o[0],0,0,0), C0,0); \
    GAPB(o[1]=__builtin_amdgcn_mfma_f32_32x32x16_bf16(PAF(0),VFR(4),o[1],0,0,0), C0,4); \
    KRD(GL,0); GAPB(o[0]=__builtin_amdgcn_mfma_f32_32x32x16_bf16(PAF(1),VFR(1),o[0],0,0,0), C0,8); \
    KRD(GL,1); GAPB(o[1]=__builtin_amdgcn_mfma_f32_32x32x16_bf16(PAF(1),VFR(5),o[1],0,0,0), C0,12); \
    KRD(GL,2); GAPB(o[0]=__builtin_amdgcn_mfma_f32_32x32x16_bf16(PAF(2),VFR(2),o[0],0,0,0), C1,0); \
    KRD(GL,3); GAPB(o[1]=__builtin_amdgcn_mfma_f32_32x32x16_bf16(PAF(2),VFR(6),o[1],0,0,0), C1,4); \
    GAPB(o[0]=__builtin_amdgcn_mfma_f32_32x32x16_bf16(PAF(3),VFR(3),o[0],0,0,0), C1,8); \
    GAPB(o[1]=__builtin_amdgcn_mfma_f32_32x32x16_bf16(PAF(3),VFR(7),o[1],0,0,0), C1,12); \
    }while(0)
  int t=1;
  #undef CMASK
  #define CMASK(P0,P1,t) do{}while(0)
  for(;t+5<NT;t+=2){
    STEP(pB0,pB1,pA0,pA1,t,true,true,true);     WAIT_BAR(2); RESC(); ROT();
    STEP(pA0,pA1,pB0,pB1,t+1,true,true,true);   WAIT_BAR(2); RESC(); ROT();
  }
  #undef CMASK
  #define CMASK(P0,P1,t) do{int jb_=(t)-(NT-4); if(jb_>=0)cmask(P0,P1,jb_,qrel,hi);}while(0)
  #define ENDW(tt) do{ if((tt)+3<NT){WAIT_BAR(2);} else if((tt)+2<NT){WAIT_BAR(1);} else {WAIT_BAR(0);} }while(0)
  for(;t+1<NT;t+=2){
    STEP(pB0,pB1,pA0,pA1,t,(t+3<NT),(t+1<NT),(t+1<NT));       ENDW(t);   RESC(); ROT();
    STEP(pA0,pA1,pB0,pB1,t+1,(t+4<NT),(t+2<NT),(t+2<NT));     ENDW(t+1); RESC(); ROT();
  }
  STEP(pB0,pB1,pA0,pA1,NT-1,false,false,false); RESC();
  { float sacc=pB0[0]+pB0[1]; _Pragma("unroll") for(int r=2;r<16;++r)sacc+=pB0[r]; _Pragma("unroll") for(int r=0;r<16;++r)sacc+=pB1[r]; l_reg+=sacc;
    pw0=(u32x4){PKW(pB0,0),PKW(pB0,2),PKW(pB0,4),PKW(pB0,6)};pw1=(u32x4){PKW(pB0,8),PKW(pB0,10),PKW(pB0,12),PKW(pB0,14)};pw2=(u32x4){PKW(pB1,0),PKW(pB1,2),PKW(pB1,4),PKW(pB1,6)};pw3=(u32x4){PKW(pB1,8),PKW(pB1,10),PKW(pB1,12),PKW(pB1,14)};
    SBAR(); pv(o,vb0+sl_cur,PAF(0),PAF(1),PAF(2),PAF(3)); }
  #undef PKW
  #undef PAF
  #undef VFR
  #undef PIN
  #undef MX3
  #undef GAPA
  #undef GAPB
  #undef EX
  #undef VRD
  #undef KRD
  #undef STEP
  #undef ENDW
  {auto rr=__builtin_amdgcn_permlane32_swap(__float_as_uint(l_reg),__float_as_uint(l_reg),false,false);l_reg=__uint_as_float(rr[0])+__uint_as_float(rr[1]);}
  if(hi==0)wsf[32+r32]=l_reg;asm volatile("s_waitcnt lgkmcnt(0)":::"memory");
  float rli[16];
  #pragma unroll
  for(int r=0;r<16;++r)rli[r]=__builtin_amdgcn_rcpf(wsf[32+crow(r,hi)]);
  bf16*Ow=O+(rowbase+q0+wid*QBLK)*OPITCH+ocol;
  { bf16*stg=(bf16*)(shm+LDS_OST)+wid*2048;
    #pragma unroll
    for(int r=0;r<16;++r){const int orow=crow(r,hi);
      #pragma unroll
      for(int d0=0;d0<2;++d0)stg[orow*64+d0*32+r32]=__float2bfloat16(o[d0][r]*rli[r]);}
    asm volatile("s_waitcnt lgkmcnt(0)":::"memory");
    #pragma unroll
    for(int i=0;i<4;++i){const int row=i*8+(lane>>3),ch=lane&7; const u32x4 v=*(const u32x4*)(stg+row*64+ch*8); ATTN_STORE16(Ow+(long)row*OPITCH+ch*8,v);} }
  asm volatile("s_waitcnt lgkmcnt(0)\n\ts_barrier":::"memory");
  #undef DMA_K
  #undef DMA_V
  #undef CMASK
  #undef START
  #undef RESC
  #undef ROT
}
constexpr int ATTN_LDS_BYTES=LDS_BYTES;
struct AttnTensors { const bf16* Q; const bf16* K; const bf16* V; bf16* O; };
struct AttnUnit { int bhh; int qb; };
struct StaticOrder {
  int vcu;
  __device__ __forceinline__ explicit StaticOrder(int v):vcu(v){}
  __device__ __forceinline__ bool next(int i,AttnUnit&u)const{ if(i>=16)return false; const int s=vcu&7,ii=i&3; u.bhh=(vcu>>3)*4+(i>>2); u.qb=(ii==0)?s:(ii==1)?15-s:(ii==2)?16+s:31-s; return true; }
};
template<class Sched,int THRL=8> __device__ __forceinline__ void attn_phase(char*lds,const AttnTensors&T,const Sched&S){
  AttnUnit u;
  for(int i=0;S.next(i,u);++i){ const int b=u.bhh>>5, hq=(u.bhh>>1)&15, vh=u.bhh&1;
    attn_unit<THRL>(b,hq*64,(hq>>1)*128+vh*64,hq*128+vh*64,u.qb,T.Q,T.K,T.V,T.O,lds); }
}
#undef SBAR
#undef WAIT_BAR
}
constexpr int NWAVES = 8;
#ifndef MK_PER_PHASE
#define MK_PER_PHASE 0
#endif
constexpr int BATCH = 4, T = 8192, D = 2048, NL = 4, FF = 8192, NIN = 8192;
constexpr int M = BATCH * T;
constexpr int NG = 64, NP = 64, NH = 16;
constexpr int SSM_L = 64, NCH = T / SSM_L;
constexpr int KT_ROWS = SSM_L + 16;
constexpr float LN_EPS = 1e-5f, RMS_EPS = 1e-5f;
constexpr float ALPHA = 1.6817928305074292f;
constexpr int PH_PER_LAYER = 9, N_PHASES = 1 + NL * PH_PER_LAYER;

constexpr size_t MiB = 1u << 20;
constexpr size_t WS_CTL = 0, CTL_ZERO_BYTES = 1 * MiB;
constexpr size_t WS_ROPEC = 1 * MiB, WS_ROPES = 5 * MiB;
constexpr size_t WS_PTAB = 9 * MiB;
constexpr size_t WS_BBRE = 18 * MiB, WS_BBIM = 19 * MiB;
constexpr size_t WS_KTAB = 20 * MiB;
constexpr size_t WS_WE = 23 * MiB, WS_WC = 39 * MiB;
constexpr size_t WS_WIN = 56 * MiB, WS_WGLU = 88 * MiB, WS_WMRG = 90 * MiB, WS_WOUT = 98 * MiB, WS_W1 = 106 * MiB, WS_W2 = 138 * MiB;
constexpr size_t WS_XB = 170 * MiB;
constexpr size_t WS_Q = 298 * MiB, WS_K = 362 * MiB, WS_V = 426 * MiB, WS_U = 490 * MiB, WS_GA = 554 * MiB, WS_GS = 682 * MiB;
constexpr size_t WS_H = 298 * MiB;
constexpr size_t WS_AS = 810 * MiB;
constexpr size_t WS_GACT = 938 * MiB;
constexpr size_t WS_END = 1002 * MiB;
static_assert(WS_PTAB + (size_t)NL * NG * 65 * NP * 8 <= WS_BBRE && WS_KTAB + (size_t)NG * KT_ROWS * 512 <= WS_WE && WS_W2 + (size_t)D * FF * 2 <= WS_XB && WS_GS + (size_t)M * 2048 * 2 <= WS_AS && WS_H + (size_t)M * FF * 2 <= WS_AS, "d_ws map");
constexpr int CW_TMO = 0, CW_CODE = 1;
constexpr int CW_BAR = 4096;

constexpr int RING_OFF = 0, RING_BYTES = 131072;
constexpr int LDSCTL_OFF = RING_BYTES, MISC_OFF = LDSCTL_OFF + 320;
constexpr int LDS_BYTES = 147456;
#define GAS __attribute__((address_space(1)))
#define LAS __attribute__((address_space(3)))
typedef unsigned short bf16;
typedef unsigned v4u __attribute__((ext_vector_type(4)));
typedef float f32x4 __attribute__((ext_vector_type(4)));
typedef short bf16x8 __attribute__((ext_vector_type(8)));
typedef GAS unsigned gu32;
typedef GAS unsigned long long gu64;
#define RLX_AGENT __ATOMIC_RELAXED, __HIP_MEMORY_SCOPE_AGENT
#define LDS_WAIT() asm volatile("s_waitcnt lgkmcnt(0)" ::: "memory")
#define VM_WAIT() asm volatile("s_waitcnt vmcnt(0)" ::: "memory")
__device__ __forceinline__ unsigned long long rt() { return __builtin_amdgcn_s_memrealtime(); }
__device__ __forceinline__ unsigned f2bf(float f) { unsigned u = __builtin_bit_cast(unsigned, f); return (u + 0x7fffu + ((u >> 16) & 1u)) >> 16; }
__device__ __forceinline__ unsigned pk2(float lo, float hi) { return f2bf(lo) | (f2bf(hi) << 16); }

#define XB_TMO      128
#define XB_XCNT(j)  (256  + 64 * (j))
#define XB_XSUB(j)  (1280 + 64 * (j))
#define XB_XGEN(j)  (2304 + 64 * (j))
#define XB_TOP      3328
#define XB_TOPGEN   3392
#define XCD_BAR_WORDS 3456
#define XB_SPIN_CAP (1u << 18)

__device__ __forceinline__ unsigned xb_ld(unsigned* p)              { return __hip_atomic_load(p, __ATOMIC_RELAXED, __HIP_MEMORY_SCOPE_AGENT); }
__device__ __forceinline__ unsigned xb_add(unsigned* p, unsigned v) { return __hip_atomic_fetch_add(p, v, __ATOMIC_RELAXED, __HIP_MEMORY_SCOPE_AGENT); }
__device__ __forceinline__ unsigned xb_xcc_id() { return (unsigned)__builtin_amdgcn_s_getreg((3 << 11) | 20) & 0xFu; }
#define XB_SPIN(cond, bar) do { unsigned _sp = 0; while (cond) { __builtin_amdgcn_s_sleep(1); \
    if ((++_sp & 255u) == 0u) { if (xb_ld(&(bar)[XB_TMO])) break; if (_sp > XB_SPIN_CAP) { atomicAdd(&(bar)[XB_TMO], 1u); break; } } } } while (0)

struct XcdBarrier {
    unsigned* bar; unsigned x;
    volatile LAS unsigned* st;
};

__device__ __forceinline__ XcdBarrier xcd_barrier_post(unsigned* bar, volatile LAS unsigned* st) {
    XcdBarrier b; b.bar = bar; b.x = xb_xcc_id(); b.st = st;
    if (threadIdx.x == 0) (void)xb_add(&bar[XB_XCNT(b.x)], 1u);
    return b;
}
__device__ __forceinline__ void xcd_barrier_complete(unsigned* bar, unsigned x, unsigned& nloc, unsigned& nx) {
    const unsigned G = gridDim.x * gridDim.y * gridDim.z;
    unsigned sum, cnt, mine, sp = 0u;
    for (;;) {
        sum = 0u; cnt = 0u; mine = 0u;
#pragma unroll
        for (unsigned j = 0; j < 16; ++j) { const unsigned c = xb_ld(&bar[XB_XCNT(j)]); sum += c; cnt += (c > 0u) ? 1u : 0u; mine = (j == x) ? c : mine; }
        if (sum == G) break;
        __builtin_amdgcn_s_sleep(1);
        if ((++sp & 255u) == 0u) { if (xb_ld(&bar[XB_TMO])) break; if (sp > XB_SPIN_CAP) { atomicAdd(&bar[XB_TMO], 1u); break; } }
    }
    nloc = mine > 0u ? mine : 1u; nx = cnt > 0u ? cnt : 1u;
}

__device__ __forceinline__ void xcd_barrier(const XcdBarrier& b) {
    asm volatile("s_waitcnt vmcnt(0)" ::: "memory");
    __syncthreads();
    if (threadIdx.x == 0) {
        unsigned* bar = b.bar;
        __builtin_amdgcn_s_waitcnt(0);
        unsigned nloc = b.st[0], nx = b.st[1];
        if (nloc == 0u) { xcd_barrier_complete(bar, b.x, nloc, nx); b.st[0] = nloc; b.st[1] = nx; }
        const unsigned old = xb_add(&bar[XB_XSUB(b.x)], 1u);
        const unsigned gen = old / nloc;
        if (old + 1u == (gen + 1u) * nloc) {
            __builtin_amdgcn_fence(__ATOMIC_RELEASE, "agent");
            asm volatile("s_waitcnt vmcnt(0)" ::: "memory");
            const unsigned og = xb_add(&bar[XB_TOP], 1u);
            const unsigned tg = og / nx;
            if (og + 1u == (tg + 1u) * nx) xb_add(&bar[XB_TOPGEN], 1u);
            else XB_SPIN(xb_ld(&bar[XB_TOPGEN]) == tg, bar);
            __builtin_amdgcn_fence(__ATOMIC_ACQUIRE, "agent");
            xb_add(&bar[XB_XGEN(b.x)], 1u);
            asm volatile("s_waitcnt vmcnt(0)" ::: "memory");
        } else {
            XB_SPIN(xb_ld(&bar[XB_XGEN(b.x)]) == gen, bar);
            __builtin_amdgcn_fence(__ATOMIC_ACQUIRE, "agent");
            asm volatile("s_waitcnt vmcnt(0)" ::: "memory");
        }
    }
    __syncthreads();
}
struct Frame {
    LAS unsigned char* lds;
    volatile LAS unsigned* MISC;
    gu32* ctl;
    int tid, lane, wave;
    int vcu, G;
    unsigned char* ws;
    const float* in[23];
    float* out;
};
__device__ __forceinline__ float wave_sum(float v) {
#pragma unroll
    for (int o = 1; o < 64; o <<= 1) v += __shfl_xor(v, o);
    return v;
}
__device__ __forceinline__ float bflo(unsigned u) { return __uint_as_float(u << 16); }
__device__ __forceinline__ float bfhi(unsigned u) { return __uint_as_float(u & 0xffff0000u); }

__device__ __forceinline__ void dsincos(double a, double& s, double& c) {
    const double q = __builtin_rint(a * 0.63661977236758134308);
    double r = __builtin_fma(-q, 1.57079632679489655800e+00, a); r = __builtin_fma(-q, 6.12323399573676603587e-17, r);
    const double z = r * r;
    double sp = -7.6471637318198164759e-13; sp = sp * z + 1.6059043836821614599e-10; sp = sp * z - 2.5052108385441718775e-08; sp = sp * z + 2.7557319223985890653e-06;
    sp = sp * z - 1.9841269841269841270e-04; sp = sp * z + 8.3333333333333333333e-03; sp = sp * z - 1.6666666666666666667e-01; const double sr = r + r * z * sp;
    double cp = 4.7794773323873852974e-14; cp = cp * z - 1.1470745597729724714e-11; cp = cp * z + 2.0876756987868098979e-09; cp = cp * z - 2.7557319223985890653e-07;
    cp = cp * z + 2.4801587301587301587e-05; cp = cp * z - 1.3888888888888888889e-03; cp = cp * z + 4.1666666666666666667e-02; cp = cp * z - 0.5; const double cr = 1.0 + z * cp;
    const int qi = (int)(long long)q & 3;
    s = (qi == 0) ? sr : (qi == 1) ? cr : (qi == 2) ? -sr : -cr;
    c = (qi == 0) ? cr : (qi == 1) ? -sr : (qi == 2) ? -cr : sr;
}
__device__ __forceinline__ double dexp(double x) {
    const double k = __builtin_rint(x * 1.44269504088896340736);
    double r = __builtin_fma(-k, 6.93147180369123816490e-01, x); r = __builtin_fma(-k, 1.90821492927058770002e-10, r);
    double p = 1.6059043836821614599e-10; p = p * r + 2.0876756987868098979e-09; p = p * r + 2.5052108385441718775e-08; p = p * r + 2.7557319223985890653e-07; p = p * r + 2.7557319223985890653e-06;
    p = p * r + 2.4801587301587301587e-05; p = p * r + 1.9841269841269841270e-04; p = p * r + 1.3888888888888888889e-03; p = p * r + 8.3333333333333333333e-03; p = p * r + 4.1666666666666666667e-02;
    p = p * r + 1.6666666666666666667e-01; p = p * r + 0.5; p = p * r + 1.0; p = p * r + 1.0;
    const long long e = (long long)k + 1023; return p * __builtin_bit_cast(double, (unsigned long long)e << 52);
}

template <bool PAIRED> __device__ __forceinline__ void transpose_item(const float* W, int K, int N, bf16* WT, int ldo, int col_off, LAS float* scr, int item, int lane) {
    const int nblk = N / 32, kb = item / nblk, nb = item % nblk, k0 = 64 * kb, n0 = 32 * nb;
#pragma unroll 8
    for (int i = 0; i < 32; ++i) { const int kk = 2 * i + (lane >> 5); scr[kk * 33 + (lane & 31)] = W[(size_t)(k0 + kk) * N + n0 + (lane & 31)]; }
    LDS_WAIT(); asm volatile("" ::: "memory");
    const int c = lane & 7;
#pragma unroll
    for (int j = 0; j < 4; ++j) { const int n = (lane >> 3) + 8 * j; const LAS float* s = scr + (8 * c) * 33 + n;
        v4u o; o.x = pk2(s[0 * 33], s[1 * 33]); o.y = pk2(s[2 * 33], s[3 * 33]); o.z = pk2(s[4 * 33], s[5 * 33]); o.w = pk2(s[6 * 33], s[7 * 33]);
        int nn = n0 + n; if (PAIRED && nn < 2048) { const int d = nn & 63; nn = (nn & ~63) + ((d < 32) ? 2 * d : 2 * (d - 32) + 1); }
        *(GAS v4u*)(WT + (size_t)nn * ldo + col_off + k0 + 8 * c) = o; }
    LDS_WAIT(); asm volatile("" ::: "memory");
}
__device__ __forceinline__ void convert_weights(Frame& F, int l) {
    LAS float* scr = (LAS float*)(F.lds + RING_OFF + F.wave * 16384);
    const int gw = F.vcu * NWAVES + F.wave, NGW = F.G * NWAVES;
    bf16* Win = (bf16*)(F.ws + WS_WIN); bf16* Wglu = (bf16*)(F.ws + WS_WGLU); bf16* Wmrg = (bf16*)(F.ws + WS_WMRG); bf16* Wout = (bf16*)(F.ws + WS_WOUT); bf16* W1 = (bf16*)(F.ws + WS_W1); bf16* W2 = (bf16*)(F.ws + WS_W2);
    const float* w_in = F.in[2] + (size_t)l * D * NIN; const float* w_glu = F.in[13] + (size_t)l * 1024 * 1024; const float* w_au = F.in[14] + (size_t)l * 1024 * D; const float* w_su = F.in[15] + (size_t)l * 1024 * D;
    const float* w_out = F.in[16] + (size_t)l * D * D; const float* w_1 = F.in[21] + (size_t)l * D * FF; const float* w_2 = F.in[22] + (size_t)l * FF * D;
    constexpr int I_IN = (D / 64) * (NIN / 32), I_GLU = (1024 / 64) * (1024 / 32), I_UP = (1024 / 64) * (D / 32), I_OUT = (D / 64) * (D / 32), I_1 = (D / 64) * (FF / 32), I_2 = (FF / 64) * (D / 32);
    constexpr int NITEMS = I_IN + I_GLU + 2 * I_UP + I_OUT + I_1 + I_2;
    for (int it = gw; it < NITEMS; it += NGW) {
        int r = it;
        if (r < I_IN) { transpose_item<true>(w_in, D, NIN, Win, D, 0, scr, r, F.lane); continue; } r -= I_IN;
        if (r < I_GLU) { transpose_item<false>(w_glu, 1024, 1024, Wglu, 1024, 0, scr, r, F.lane); continue; } r -= I_GLU;
        if (r < I_UP) { transpose_item<false>(w_au, 1024, D, Wmrg, 2048, 0, scr, r, F.lane); continue; } r -= I_UP;
        if (r < I_UP) { transpose_item<false>(w_su, 1024, D, Wmrg, 2048, 1024, scr, r, F.lane); continue; } r -= I_UP;
        if (r < I_OUT) { transpose_item<false>(w_out, D, D, Wout, D, 0, scr, r, F.lane); continue; } r -= I_OUT;
        if (r < I_1) { transpose_item<false>(w_1, D, FF, W1, D, 0, scr, r, F.lane); continue; } r -= I_1;
        transpose_item<false>(w_2, FF, D, W2, FF, 0, scr, r, F.lane);
    }
}

__device__ __forceinline__ void pro_phase(Frame& F) {
    const int gw = F.vcu * NWAVES + F.wave, NGW = F.G * NWAVES, lane = F.lane;
    {
        const int i = lane & 31; const double inv = dexp(-(double)(2 * i) * (9.21034037197618273607 / 64.0));
        const int* pos = (const int*)F.in[1]; float* rc = (float*)(F.ws + WS_ROPEC); float* rs = (float*)(F.ws + WS_ROPES);
        for (int m = gw; m < M; m += NGW) { double s, c; dsincos((double)pos[m] * inv, s, c); if (lane < 32) rc[(size_t)m * 32 + i] = (float)c; else rs[(size_t)m * 32 + i] = (float)s; }
    }
    {
        float* PT = (float*)(F.ws + WS_PTAB);
        for (int it = gw; it < NL * NG * 65; it += NGW) { const int lg = it / 65, tau = it % 65;
            const double dt = dexp((double)F.in[7][lg]), are = (double)F.in[5][lg * NP + lane], aim = (double)F.in[6][lg * NP + lane];
            const double mag = dexp((double)tau * dt * are); double s, c; dsincos((double)tau * dt * aim, s, c);
            *(float2*)(PT + ((size_t)it * NP + lane) * 2) = make_float2((float)(mag * c), (float)(mag * s)); }
    }
    {
        float* BR = (float*)(F.ws + WS_BBRE); float* BI = (float*)(F.ws + WS_BBIM);
        for (int lg = gw; lg < NL * NG; lg += NGW) {
            const double dt = dexp((double)F.in[7][lg]), are = (double)F.in[5][lg * NP + lane], aim = (double)F.in[6][lg * NP + lane];
            const double mag = dexp(dt * are); double s, c; dsincos(dt * aim, s, c);
            const double nr = mag * c - 1.0, ni = mag * s, den = are * are + aim * aim, zr = (nr * are + ni * aim) / den, zi = (ni * are - nr * aim) / den;
            const size_t o = ((size_t)lg * NP + lane) * NH;
#pragma unroll
            for (int h = 0; h < NH; ++h) { const double br = (double)F.in[8][o + h], bi = (double)F.in[9][o + h]; BR[o + h] = (float)(zr * br - zi * bi); BI[o + h] = (float)(zr * bi + zi * br); }
        }
    }
    {
        const GAS f32x4* x4 = (const GAS f32x4*)F.in[0]; GAS v4u* xb = (GAS v4u*)(F.ws + WS_XB);
        for (size_t i = (size_t)gw * 64 + lane; i < (size_t)M * D / 8; i += (size_t)NGW * 64) { const f32x4 a = x4[2 * i], b = x4[2 * i + 1]; v4u o; o.x = pk2(a.x, a.y); o.y = pk2(a.z, a.w); o.z = pk2(b.x, b.y); o.w = pk2(b.z, b.w); xb[i] = o; }
    }
    convert_weights(F, 0);
}

__device__ __forceinline__ void ssm_tables(Frame& F, int l) {
    const int gw = F.vcu * NWAVES + F.wave, NGW = F.G * NWAVES, lane = F.lane;
    const float* PT = (const float*)(F.ws + WS_PTAB) + (size_t)l * NG * 65 * NP * 2; const float* BR = (const float*)(F.ws + WS_BBRE) + (size_t)l * NG * NP * NH; const float* BI = (const float*)(F.ws + WS_BBIM) + (size_t)l * NG * NP * NH;
    const float* CR = F.in[10] + (size_t)l * NG * NH * NP; const float* CI = F.in[11] + (size_t)l * NG * NH * NP; const float* DS = F.in[12] + (size_t)l * NG * NH;
    bf16* WE = (bf16*)(F.ws + WS_WE); bf16* WC = (bf16*)(F.ws + WS_WC); bf16* KT = (bf16*)(F.ws + WS_KTAB);
    constexpr int I_WE = NG * 64, I_WC = NG * 64, I_KT = NG * KT_ROWS;
    for (int it = gw; it < I_WE + I_WC + I_KT; it += NGW) {
        if (it < I_WE) { const int g = it >> 6, j = it & 63;
#pragma unroll
            for (int e = 0; e < 2; ++e) { const int n = 2 * lane + e, p = n & 63, ri = n >> 6; const float2 pw = *(const float2*)(PT + ((size_t)(g * 65 + (63 - j)) * NP + p) * 2);
                const float* br = BR + ((size_t)g * NP + p) * NH; const float* bi = BI + ((size_t)g * NP + p) * NH; float v[16];
#pragma unroll
                for (int h = 0; h < 16; ++h) v[h] = ri ? (pw.x * bi[h] + pw.y * br[h]) : (pw.x * br[h] - pw.y * bi[h]);
                GAS v4u* o = (GAS v4u*)(WE + (((size_t)g * 64 + j) * 128 + n) * 16);
                v4u a, b; a.x = pk2(v[0], v[1]); a.y = pk2(v[2], v[3]); a.z = pk2(v[4], v[5]); a.w = pk2(v[6], v[7]); b.x = pk2(v[8], v[9]); b.y = pk2(v[10], v[11]); b.z = pk2(v[12], v[13]); b.w = pk2(v[14], v[15]); o[0] = a; o[1] = b; }
        } else if (it < I_WE + I_WC) { const int r = it - I_WE, g = r >> 6, j = r & 63;
            const int ho = lane >> 2, kq = lane & 3, ri = kq >> 1, p0 = (kq & 1) * 32;
            const float* cr = CR + ((size_t)g * NH + ho) * NP + p0; const float* ci = CI + ((size_t)g * NH + ho) * NP + p0; const float* pw = PT + ((size_t)(g * 65 + (j + 1)) * NP + p0) * 2;
            GAS v4u* o = (GAS v4u*)(WC + (((size_t)g * 1024 + j * 16 + ho) * 128 + kq * 32));
#pragma unroll
            for (int q = 0; q < 4; ++q) { float v[8];
#pragma unroll
                for (int e = 0; e < 8; ++e) { const int p = q * 8 + e; const float c_r = cr[p], c_i = ci[p], pr = pw[2 * p], pi = pw[2 * p + 1]; v[e] = ri ? -(c_r * pi + c_i * pr) : (c_r * pr - c_i * pi); }
                v4u a; a.x = pk2(v[0], v[1]); a.y = pk2(v[2], v[3]); a.z = pk2(v[4], v[5]); a.w = pk2(v[6], v[7]); o[q] = a; }
        } else { const int r = it - I_WE - I_WC, g = r / KT_ROWS, row = r % KT_ROWS, tau = row - 16;
            const int ho = lane >> 2, h0 = 4 * (lane & 3); float s0 = 0.f, s1 = 0.f, s2 = 0.f, s3 = 0.f;
            if (tau >= 0) {
                const float* cr = CR + ((size_t)g * NH + ho) * NP; const float* ci = CI + ((size_t)g * NH + ho) * NP; const float* pw = PT + ((size_t)(g * 65 + tau) * NP) * 2;
                for (int p = 0; p < NP; ++p) { const float c_r = cr[p], c_i = ci[p], pr = pw[2 * p], pi = pw[2 * p + 1], xr = c_r * pr - c_i * pi, xi = c_r * pi + c_i * pr;
                    const f32x4 br = *(const f32x4*)(BR + ((size_t)g * NP + p) * NH + h0), bi = *(const f32x4*)(BI + ((size_t)g * NP + p) * NH + h0);
                    s0 += xr * br.x - xi * bi.x; s1 += xr * br.y - xi * bi.y; s2 += xr * br.z - xi * bi.z; s3 += xr * br.w - xi * bi.w; }
                if (tau == 0) { const float d = DS[g * NH + ho]; if (ho == h0) s0 += d; if (ho == h0 + 1) s1 += d; if (ho == h0 + 2) s2 += d; if (ho == h0 + 3) s3 += d; }
            }
            *(GAS unsigned long long*)(KT + ((size_t)(g * KT_ROWS + row) * 256 + lane * 4)) = (unsigned long long)pk2(s0, s1) | ((unsigned long long)pk2(s2, s3) << 32);
        }
    }
}

typedef float f32x16 __attribute__((ext_vector_type(16)));
__device__ __forceinline__ int crow16(int r, int hi) { return (r & 3) + 8 * (r >> 2) + 4 * hi; }
constexpr int SSM_E_STRIDE = 132, SSM_HP_STRIDE = 136;
constexpr int SSM_E_OFF = 0, SSM_HP_OFF = 128 * SSM_E_STRIDE * 4, SSM_KT_OFF = 0;
static_assert(SSM_HP_OFF + 128 * SSM_HP_STRIDE * 2 <= RING_BYTES && KT_ROWS * 512 <= SSM_HP_OFF, "ssm LDS map");
__device__ __forceinline__ void ssm_unit(Frame& F, int l, int b, int g) {
    const int lane = F.lane, wid = F.wave, r32 = lane & 31, hi = lane >> 5, rt = wid & 3, ng = wid >> 2;
    const bf16* Ug = (const bf16*)(F.ws + WS_U) + ((size_t)g * M + (size_t)b * T) * 16;
    const bf16* WEg = (const bf16*)(F.ws + WS_WE) + (size_t)g * 64 * 128 * 16;
    const bf16* WCg = (const bf16*)(F.ws + WS_WC) + (size_t)g * 1024 * 128;
    const bf16* KTg = (const bf16*)(F.ws + WS_KTAB) + (size_t)g * KT_ROWS * 256;
    LAS float* E = (LAS float*)(F.lds + SSM_E_OFF); LAS bf16* HP = (LAS bf16*)(F.lds + SSM_HP_OFF); LAS unsigned char* KTl = F.lds + SSM_KT_OFF;
    const bf16* ua = Ug + ((size_t)(32 * rt + r32) * 64) * 16 + 8 * hi;
    {
        const bf16* wb = WEg + (size_t)(64 * ng + r32) * 16 + 8 * hi;
        f32x16 e0 = {}, e1 = {};
#pragma unroll 8
        for (int j = 0; j < 64; ++j) { const bf16x8 a = *(const bf16x8*)(ua + j * 16), b0 = *(const bf16x8*)(wb + j * 2048), b1 = *(const bf16x8*)(wb + j * 2048 + 512);
            e0 = __builtin_amdgcn_mfma_f32_32x32x16_bf16(a, b0, e0, 0, 0, 0); e1 = __builtin_amdgcn_mfma_f32_32x32x16_bf16(a, b1, e1, 0, 0, 0); }
#pragma unroll
        for (int r = 0; r < 16; ++r) { LAS float* row = E + (32 * rt + crow16(r, hi)) * SSM_E_STRIDE + 64 * ng + r32; row[0] = e0[r]; row[32] = e1[r]; }
    }
    __syncthreads();
    if (wid == 0) {
        const float2 al = *(const float2*)((const float*)(F.ws + WS_PTAB) + (((size_t)(l * NG + g) * 65 + 64) * NP + lane) * 2);
        float hr = 0.f, hi_ = 0.f;
#pragma unroll 8
        for (int c = 0; c < NCH; ++c) { HP[c * SSM_HP_STRIDE + lane] = (bf16)f2bf(hr); HP[c * SSM_HP_STRIDE + 64 + lane] = (bf16)f2bf(hi_);
            const float er = E[c * SSM_E_STRIDE + lane], ei = E[c * SSM_E_STRIDE + 64 + lane];
            const float nr = al.x * hr - al.y * hi_ + er, ni = al.x * hi_ + al.y * hr + ei; hr = nr; hi_ = ni; }
    }
    __syncthreads();
    for (int i = F.tid; i < KT_ROWS * 512 / 16; i += NWAVES * 64) *(LAS v4u*)(KTl + i * 16) = *(const GAS v4u*)((const GAS unsigned char*)KTg + (size_t)i * 16);
    __syncthreads();
    {
        bf16x8 hf[8];
#pragma unroll
        for (int ks = 0; ks < 8; ++ks) hf[ks] = *(const LAS bf16x8*)(HP + (32 * rt + r32) * SSM_HP_STRIDE + 16 * ks + 8 * hi);
        const int jj = r32 >> 4, ho = r32 & 15;
        const LAS unsigned char* ktl = KTl + (jj + 16) * 512 + ho * 32 + hi * 16;
        bf16* gact = (bf16*)(F.ws + WS_GACT) + ((size_t)b * T + (size_t)(32 * rt) * 64 + jj) * 1024 + 16 * g + ho;
        for (int q = 0; q < 4; ++q) {
            f32x16 acc[4];
#pragma unroll
            for (int k = 0; k < 4; ++k) acc[k] = (f32x16){};
#pragma unroll
            for (int k = 0; k < 4; ++k) { const int jp = 8 * q + 2 * k + ng; const bf16* wc = WCg + (size_t)(32 * jp + r32) * 128 + 8 * hi;
                bf16x8 wf[8];
#pragma unroll
                for (int ks = 0; ks < 8; ++ks) wf[ks] = *(const bf16x8*)(wc + 16 * ks);
#pragma unroll
                for (int ks = 0; ks < 8; ++ks) acc[k] = __builtin_amdgcn_mfma_f32_32x32x16_bf16(hf[ks], wf[ks], acc[k], 0, 0, 0);
                asm volatile("" ::: "memory"); }
            const int NI = 16 * q + 16, jb = 2 * (8 * q + ng);
            bf16x8 A0[4], A1[4];
#define SSM_LDA(dst, ib) do { _Pragma("unroll") for (int e = 0; e < 4; ++e) dst[e] = *(const bf16x8*)(ua + ((ib) + e) * 16); } while (0)
#define SSM_CMP(src, ib) do { _Pragma("unroll") for (int e = 0; e < 4; ++e) { const LAS unsigned char* kp = ktl + (jb - ((ib) + e)) * 512; _Pragma("unroll") for (int k = 0; k < 4; ++k) { \
                const bf16x8 kf = *(const LAS bf16x8*)(kp + k * 2048); acc[k] = __builtin_amdgcn_mfma_f32_32x32x16_bf16(src[e], kf, acc[k], 0, 0, 0); } } } while (0)
            SSM_LDA(A0, 0);
            for (int ib = 0; ib < NI; ib += 8) { SSM_LDA(A1, ib + 4); SSM_CMP(A0, ib); if (ib + 8 < NI) SSM_LDA(A0, ib + 8); SSM_CMP(A1, ib + 4); }
#undef SSM_LDA
#undef SSM_CMP
#pragma unroll
            for (int k = 0; k < 4; ++k) { const int jp = 8 * q + 2 * k + ng;
#pragma unroll
                for (int r = 0; r < 16; ++r) { const float y = acc[k][r], u2 = 1.5957691216057308f * (y + 0.044715f * y * y * y);
                    const float gl = y * __builtin_amdgcn_rcpf(1.0f + __builtin_amdgcn_exp2f(-1.4426950408889634f * u2));
                    gact[(size_t)(crow16(r, hi) * 64 + 2 * jp) * 1024] = (bf16)f2bf(gl); } }
        }
    }
    __syncthreads();
}

__device__ __forceinline__ void combine_phase(Frame& F, int l) {
    const int gw = F.vcu * NWAVES + F.wave, NGW = F.G * NWAVES, lane = F.lane;
    const float* lq = F.in[3] + l * 256;
    const float s1 = wave_sum(lq[lane] * lq[64 + lane]), s2 = wave_sum(lq[128 + lane] * lq[192 + lane]);
    const float lam_init = 0.8f - 0.6f * __expf(-0.3f * (float)l), lam = __expf(s1) - __expf(s2) + lam_init, post = 1.0f - lam_init;
    const int h = lane >> 3, e0 = (lane & 7) * 16;
    float gs[16];
#pragma unroll
    for (int e = 0; e < 16; ++e) gs[e] = F.in[4][l * 128 + e0 + e] * post;
    const bf16* O4 = (const bf16*)(F.ws + WS_XB); bf16* AS = (bf16*)(F.ws + WS_AS);
    for (int m = gw; m < M; m += NGW) {
        const GAS v4u* p0 = (const GAS v4u*)(O4 + (size_t)m * 2048 + (h * 2) * 128 + e0); const GAS v4u* p1 = (const GAS v4u*)(O4 + (size_t)m * 2048 + (h * 2 + 1) * 128 + e0);
        const v4u a0 = p0[0], a1 = p0[1], b0 = p1[0], b1 = p1[1];
        float d[16];
        d[0] = bflo(a0.x) - lam * bflo(b0.x); d[1] = bfhi(a0.x) - lam * bfhi(b0.x); d[2] = bflo(a0.y) - lam * bflo(b0.y); d[3] = bfhi(a0.y) - lam * bfhi(b0.y);
        d[4] = bflo(a0.z) - lam * bflo(b0.z); d[5] = bfhi(a0.z) - lam * bfhi(b0.z); d[6] = bflo(a0.w) - lam * bflo(b0.w); d[7] = bfhi(a0.w) - lam * bfhi(b0.w);
        d[8] = bflo(a1.x) - lam * bflo(b1.x); d[9] = bfhi(a1.x) - lam * bfhi(b1.x); d[10] = bflo(a1.y) - lam * bflo(b1.y); d[11] = bfhi(a1.y) - lam * bfhi(b1.y);
        d[12] = bflo(a1.z) - lam * bflo(b1.z); d[13] = bfhi(a1.z) - lam * bfhi(b1.z); d[14] = bflo(a1.w) - lam * bflo(b1.w); d[15] = bfhi(a1.w) - lam * bfhi(b1.w);
        float ss = 0.f;
#pragma unroll
        for (int e = 0; e < 16; ++e) ss += d[e] * d[e];
        ss += __shfl_xor(ss, 1); ss += __shfl_xor(ss, 2); ss += __shfl_xor(ss, 4);
        const float rs = 1.0f / sqrtf(ss * (1.0f / 128.0f) + RMS_EPS);
        v4u o0, o1;
        o0.x = pk2(d[0] * rs * gs[0], d[1] * rs * gs[1]); o0.y = pk2(d[2] * rs * gs[2], d[3] * rs * gs[3]); o0.z = pk2(d[4] * rs * gs[4], d[5] * rs * gs[5]); o0.w = pk2(d[6] * rs * gs[6], d[7] * rs * gs[7]);
        o1.x = pk2(d[8] * rs * gs[8], d[9] * rs * gs[9]); o1.y = pk2(d[10] * rs * gs[10], d[11] * rs * gs[11]); o1.z = pk2(d[12] * rs * gs[12], d[13] * rs * gs[13]); o1.w = pk2(d[14] * rs * gs[14], d[15] * rs * gs[15]);
        GAS v4u* po = (GAS v4u*)(AS + (size_t)m * 2048 + h * 128 + e0); po[0] = o0; po[1] = o1;
    }
}

__device__ __forceinline__ void ln_phase(Frame& F, const float* gam, const float* bet) {
    const int gw = F.vcu * NWAVES + F.wave, NGW = F.G * NWAVES, lane = F.lane;
    f32x4 gv[8], bv[8];
#pragma unroll
    for (int j = 0; j < 8; ++j) { gv[j] = ((const GAS f32x4*)gam)[64 * j + lane]; bv[j] = ((const GAS f32x4*)bet)[64 * j + lane]; }
    bf16* XB = (bf16*)(F.ws + WS_XB);
    for (int m = gw; m < M; m += NGW) {
        GAS f32x4* xr = (GAS f32x4*)(F.out + (size_t)m * D) + lane;
        f32x4 v[8]; float s = 0.f;
#pragma unroll
        for (int j = 0; j < 8; ++j) { v[j] = xr[64 * j]; s += (v[j].x + v[j].y) + (v[j].z + v[j].w); }
        const float mean = wave_sum(s) * (1.f / D); float s2 = 0.f;
#pragma unroll
        for (int j = 0; j < 8; ++j) { v[j] = v[j] - mean; s2 += (v[j].x * v[j].x + v[j].y * v[j].y) + (v[j].z * v[j].z + v[j].w * v[j].w); }
        const float rstd = 1.f / sqrtf(wave_sum(s2) * (1.f / D) + LN_EPS);
        GAS unsigned long long* o8 = (GAS unsigned long long*)(XB + (size_t)m * D) + lane;
#pragma unroll
        for (int j = 0; j < 8; ++j) { f32x4 o = v[j] * rstd * gv[j] + bv[j];
#ifdef DBG_SANITIZE
            for (int e = 0; e < 4; ++e) if (!(fabsf(o[e]) < 1e30f)) o[e] = 1000.0f;
#endif
            xr[64 * j] = o; o8[64 * j] = (unsigned long long)pk2(o.x, o.y) | ((unsigned long long)pk2(o.z, o.w) << 32); }
    }
}

struct Args { const float* in[23]; float* out; unsigned char* ws; int ph_lo, ph_hi; };
__global__ void __launch_bounds__(NWAVES * 64, 2) mk_fwd(Args args) {
    extern __shared__ __attribute__((aligned(16))) unsigned char lds[];
    Frame F;
    F.lds = (LAS unsigned char*)lds;
    F.MISC = (volatile LAS unsigned*)(F.lds + MISC_OFF);
    F.tid = threadIdx.x; F.lane = F.tid & 63; F.wave = __builtin_amdgcn_readfirstlane(F.tid >> 6);
    F.G = gridDim.x; { const int bx = blockIdx.x; F.vcu = (F.G % 8 == 0) ? (bx % 8) * (F.G / 8) + bx / 8 : bx; }
    F.ws = args.ws; F.ctl = (gu32*)(args.ws + WS_CTL); F.out = args.out;
#pragma unroll
    for (int i = 0; i < 23; ++i) F.in[i] = args.in[i];
    for (int u = F.tid; u < (LDS_BYTES - LDSCTL_OFF) / 4; u += NWAVES * 64) ((LAS unsigned*)(F.lds + LDSCTL_OFF))[u] = 0u;
    __syncthreads();
    XcdBarrier bar; bar.bar = (unsigned*)(F.ctl + CW_BAR); bar.x = 0; bar.st = nullptr;
    if (!MK_PER_PHASE) bar = xcd_barrier_post((unsigned*)(F.ctl + CW_BAR), F.MISC + 8);
    const int lo = args.ph_lo, hi = args.ph_hi;
#ifndef PM
#define PM 0x3ff
#endif
#define PMK(j) (((PM) >> (j)) & 1)
#define IN(k) (lo <= (k) && (k) < hi)
#define REFRESH() do { F.tid = opaque_tid(); F.lane = F.tid & 63; F.wave = __builtin_amdgcn_readfirstlane(F.tid >> 6); } while (0)
#define SEAM(k) do { if (IN((k) + 1)) xcd_barrier(bar); } while (0)

    bf16* const Win = (bf16*)(F.ws + WS_WIN); bf16* const Wglu = (bf16*)(F.ws + WS_WGLU); bf16* const Wmrg = (bf16*)(F.ws + WS_WMRG); bf16* const Wout = (bf16*)(F.ws + WS_WOUT); bf16* const W1 = (bf16*)(F.ws + WS_W1); bf16* const W2 = (bf16*)(F.ws + WS_W2);
    bf16* const XB = (bf16*)(F.ws + WS_XB); bf16* const Qb = (bf16*)(F.ws + WS_Q); bf16* const Kb = (bf16*)(F.ws + WS_K); bf16* const Vb = (bf16*)(F.ws + WS_V); bf16* const Ub = (bf16*)(F.ws + WS_U);
    bf16* const GA = (bf16*)(F.ws + WS_GA); bf16* const GS = (bf16*)(F.ws + WS_GS); bf16* const HB = (bf16*)(F.ws + WS_H); bf16* const AS = (bf16*)(F.ws + WS_AS); bf16* const GACT = (bf16*)(F.ws + WS_GACT);

    if (PMK(0) && IN(0)) { REFRESH(); pro_phase(F); SEAM(0); }

    for (int l = 0; l < NL; ++l) {
        const int p0 = 1 + l * PH_PER_LAYER;
        if (PMK(1) && IN(p0 + 0)) { REFRESH();
            ssm_tables(F, l);
            pg8::Gemm g{XB, Win, M, NIN, D}; pg8::StaticOrder S; S.init(M, NIN, F.G, (int)blockIdx.x);
            pg8::EpiInProj E{Qb, Kb, Vb, Ub, GA, GS, (const float*)(F.ws + WS_ROPEC), (const float*)(F.ws + WS_ROPES)};
            pg8::gemm_phase<pg8::EpiInProj, pg8::StaticOrder, true, true>(F.lds + RING_OFF, g, S, E);
            SEAM(p0 + 0);
        }
        if (PMK(2) && IN(p0 + 1)) { REFRESH();
#ifdef DBG_NO_SSM
            { GAS v4u* z = (GAS v4u*)GACT; for (size_t i = (size_t)(F.vcu * NWAVES + F.wave) * 64 + F.lane; i < (size_t)M * 1024 / 8; i += (size_t)F.G * NWAVES * 64) z[i] = (v4u){0u, 0u, 0u, 0u}; }
#else
            for (int u = F.vcu; u < BATCH * NG; u += F.G) ssm_unit(F, l, u & 3, u >> 2);
#endif
#ifdef DBG_NO_ATTN
            { GAS v4u* z = (GAS v4u*)XB; for (size_t i = (size_t)(F.vcu * NWAVES + F.wave) * 64 + F.lane; i < (size_t)M * 2048 / 8; i += (size_t)F.G * NWAVES * 64) z[i] = (v4u){0u, 0u, 0u, 0u}; }
#else
            const attn_body::AttnTensors AT{(const attn_body::bf16*)Qb, (const attn_body::bf16*)Kb, (const attn_body::bf16*)Vb, (attn_body::bf16*)XB};
            const attn_body::StaticOrder S(F.vcu);
            attn_body::attn_phase<attn_body::StaticOrder>((char*)lds + RING_OFF, AT, S);
#endif
            SEAM(p0 + 1);
        }
        if (PMK(3) && IN(p0 + 2)) { REFRESH();
            combine_phase(F, l);
            pg8::Gemm g{GACT, Wglu, M, 1024, 1024}; pg8::StaticOrder S; S.init(M, 1024, F.G, (int)blockIdx.x);
            pg8::EpiGlu E{GACT, AS};
            pg8::gemm_phase<pg8::EpiGlu, pg8::StaticOrder, true, true>(F.lds + RING_OFF, g, S, E);
            SEAM(p0 + 2);
        }
        if (PMK(4) && IN(p0 + 3)) { REFRESH();
            pg8::Gemm g{AS, Wmrg, M, D, 2048}; pg8::StaticOrder S; S.init(M, D, F.G, (int)blockIdx.x);
            pg8::EpiMerge E{GA, GS};
            pg8::gemm_phase<pg8::EpiMerge, pg8::StaticOrder, true, true>(F.lds + RING_OFF, g, S, E);
            SEAM(p0 + 3);
        }
        if (PMK(5) && IN(p0 + 4)) { REFRESH();
            pg8::Gemm g{GA, Wout, M, D, D}; pg8::StaticOrder S; S.init(M, D, F.G, (int)blockIdx.x);
            pg8::EpiResF32 E{l == 0 ? F.in[0] : F.out, F.out, ALPHA};
            pg8::gemm_phase<pg8::EpiResF32, pg8::StaticOrder, true, true>(F.lds + RING_OFF, g, S, E);
            SEAM(p0 + 4);
        }
        if (PMK(6) && IN(p0 + 5)) { REFRESH(); ln_phase(F, F.in[17] + l * D, F.in[18] + l * D); SEAM(p0 + 5); }
        if (PMK(7) && IN(p0 + 6)) { REFRESH();
            pg8::Gemm g{XB, W1, M, FF, D}; pg8::StaticOrder S; S.init(M, FF, F.G, (int)blockIdx.x);
            pg8::EpiRelu2 E{HB};
            pg8::gemm_phase<pg8::EpiRelu2, pg8::StaticOrder, true, true>(F.lds + RING_OFF, g, S, E);
            SEAM(p0 + 6);
        }
        if (PMK(8) && IN(p0 + 7)) { REFRESH();
            pg8::Gemm g{HB, W2, M, D, FF}; pg8::StaticOrder S; S.init(M, D, F.G, (int)blockIdx.x);
            pg8::EpiResF32 E{F.out, F.out, ALPHA};
            pg8::gemm_phase<pg8::EpiResF32, pg8::StaticOrder, true, true>(F.lds + RING_OFF, g, S, E);
            SEAM(p0 + 7);
        }
        if (PMK(9) && IN(p0 + 8)) { REFRESH();
            ln_phase(F, F.in[19] + l * D, F.in[20] + l * D);
            if (l + 1 < NL) { __syncthreads(); convert_weights(F, l + 1); }
            if (l + 1 < NL) SEAM(p0 + 8);
        }
    }
#undef IN
#undef SEAM
}

#ifdef DBG_DIAG
__global__ void diag_sum(const unsigned* p, size_t nwords, unsigned long long* slot) {
    unsigned long long s = 0; for (size_t i = (size_t)blockIdx.x * blockDim.x + threadIdx.x; i < nwords; i += (size_t)gridDim.x * blockDim.x) s += (unsigned long long)p[i] * (1u + (unsigned)(i & 1023u));
    for (int o = 1; o < 64; o <<= 1) s += __shfl_xor(s, o);
    if ((threadIdx.x & 63) == 0) atomicAdd(slot, s);
}
__global__ void diag_fill(float* out, size_t n, const unsigned long long* chk) {
    for (size_t i = (size_t)blockIdx.x * blockDim.x + threadIdx.x; i < n; i += (size_t)gridDim.x * blockDim.x) {
        int r = 0; size_t lo = 0, sz = n / 8 * 7; while (r < 6 && i >= lo + sz) { lo += sz; sz /= 8; ++r; }
        unsigned long long h = chk[r] ^ ((unsigned long long)i * 0x9E3779B97F4A7C15ull); h ^= h >> 29; h *= 0xBF58476D1CE4E5B9ull; h ^= h >> 32;
        out[i] = 1.0f + (float)(h & 0xFFFF) * (1.0f / 65536.0f);
    }
}
#endif
extern "C" void kernel_launch(void* const* d_in, const int* in_sizes, int n_in, void* d_out, int out_size, void* d_ws, size_t ws_size, hipStream_t stream) {
    static int grid = 0;
    if (grid == 0) {
        if (n_in != 23 || in_sizes[0] != M * D || out_size != M * D || ws_size < WS_END) { fprintf(stderr, "kernel_launch: unexpected problem shape (n_in %d, in0 %d, out %d, ws %zu); nothing launched\n", n_in, n_in > 0 ? in_sizes[0] : -1, out_size, ws_size); grid = -1; return; }
        int dev = 0, cus = 0, per_cu = 0;
        if (hipGetDevice(&dev) != hipSuccess || hipDeviceGetAttribute(&cus, hipDeviceAttributeMultiprocessorCount, dev) != hipSuccess) { grid = -1; return; }
        if (hipFuncSetAttribute((const void*)mk_fwd, hipFuncAttributeMaxDynamicSharedMemorySize, LDS_BYTES) != hipSuccess) { fprintf(stderr, "kernel_launch: hipFuncSetAttribute failed\n"); grid = -1; return; }
        if (hipOccupancyMaxActiveBlocksPerMultiprocessor(&per_cu, (const void*)mk_fwd, NWAVES * 64, LDS_BYTES) != hipSuccess || per_cu < 1) { fprintf(stderr, "kernel_launch: occupancy query reports %d workgroups per CU\n", per_cu); }
        (void)hipGetLastError();
        grid = cus;
    }
    if (grid < 0) return;
    if (hipMemsetAsync((char*)d_ws + WS_CTL, 0, CTL_ZERO_BYTES, stream) != hipSuccess) return;
    Args a{};
    for (int i = 0; i < 23; ++i) a.in[i] = (const float*)d_in[i];
    a.out = (float*)d_out; a.ws = (unsigned char*)d_ws;
#if MK_PER_PHASE
#ifdef DBG_DIAG
    unsigned long long* chk = (unsigned long long*)((char*)d_ws + 512 * 1024);
    auto SUM = [&](size_t off_mib, size_t len_mib, int r) { hipLaunchKernelGGL(diag_sum, dim3(2048), dim3(256), 0, stream, (const unsigned*)((char*)d_ws + off_mib * MiB), len_mib * MiB / 4, chk + r); };
    auto SUMO = [&](int r) { hipLaunchKernelGGL(diag_sum, dim3(2048), dim3(256), 0, stream, (const unsigned*)d_out, (size_t)M * D, chk + r); };
    auto RUN = [&](int p) { a.ph_lo = p; a.ph_hi = p + 1; hipLaunchKernelGGL(mk_fwd, dim3(grid), dim3(NWAVES * 64), LDS_BYTES, stream, a); };
    RUN(0); RUN(7); SUM(298, 512, 0);
    RUN(1); SUM(682, 128, 1); SUM(554, 128, 2); SUM(490, 64, 3); SUM(426, 64, 4); SUM(362, 64, 5); SUM(298, 64, 6);
    hipLaunchKernelGGL(diag_fill, dim3(2048), dim3(256), 0, stream, (float*)d_out, (size_t)M * D, (const unsigned long long*)chk);
#else
    for (int p = 0; p < N_PHASES; ++p) { a.ph_lo = p; a.ph_hi = p + 1; hipLaunchKernelGGL(mk_fwd, dim3(grid), dim3(NWAVES * 64), LDS_BYTES, stream, a); }
#endif
#else
    a.ph_lo = 0; a.ph_hi = N_PHASES;
    hipLaunchKernelGGL(mk_fwd, dim3(grid), dim3(NWAVES * 64), LDS_BYTES, stream, a);
#endif
    const hipError_t le = hipPeekAtLastError();
    if (le != hipSuccess) fprintf(stderr, "kernel_launch: launch failed: %s\n", hipGetErrorName(le));
}
```

```cpp
#include <hip/hip_runtime.h>
#include <cstdio>
#include <cstdint>
__device__ __forceinline__ int opaque_tid() { int t = threadIdx.x; asm volatile("" : "+v"(t)); return t; }
namespace pg8 {
#define PG8_LAS __attribute__((address_space(3)))
typedef unsigned short bf16_t;
typedef short bf16x8 __attribute__((ext_vector_type(8)));
typedef float f32x4 __attribute__((ext_vector_type(4)));
typedef unsigned u32x4 __attribute__((ext_vector_type(4)));
constexpr int BM = 256, BK = 64, HALF = 128, HTB = HALF * BK * 2  , STAGE_BYTES = 8 * HTB, NXCD = 8, WGM = 8;

__host__ __device__ __forceinline__ int lds_byte(int r, int c) { const int st = (r >> 4) * 2 + (c >> 5), rr = r & 15, cc = c & 31, ob = rr * 64 + cc * 2; return st * 1024 + (ob ^ (((ob >> 9) & 1) << 5)); }
__host__ __device__ __forceinline__ void stage_rc(int b, int& R, int& C) { const int st = b / 1024, sb = b % 1024, swz = sb ^ (((sb >> 9) & 1) << 5); R = (st >> 1) * 16 + swz / 64; C = (st & 1) * 32 + (swz % 64) / 2; }
__host__ __device__ __forceinline__ int perm32(int rho) { const int n = rho >> 4, i = rho & 15; return 8 * (i >> 2) + 4 * n + (i & 3); }

struct Unit { int pm, pn; };
struct Gemm { const bf16_t* A; const bf16_t* Bt; int M, N, K; };

struct StaticOrder {
    int nM, nN, nwg, G, c;
    __host__ __device__ void init(int M, int N, int G_, int c_) { nM = M / BM; nN = N / BM; nwg = nM * nN; G = G_; c = c_; }
    __host__ __device__ bool next(int i, Unit& u) const {
        const long L = (long)i * G + c; if (L >= nwg) return false;
        int wgid = (int)L; { const int q = nwg / NXCD, r = nwg % NXCD, xcd = wgid % NXCD, off = wgid / NXCD; wgid = (xcd < r ? xcd * (q + 1) : r * (q + 1) + (xcd - r) * q) + off; }
        const int nig = WGM * nN, gid = wgid / nig, fm = gid * WGM, gsz = (nM - fm) < WGM ? (nM - fm) : WGM;
        u.pm = fm + ((wgid % nig) % gsz); u.pn = (wgid % nig) / gsz; return true;
    }
    __device__ __forceinline__ void a_ready(const Unit&) const {}
    __device__ __forceinline__ void done(const Unit&) const {}
};

__device__ __forceinline__ unsigned cvt_pk_bf16(float lo, float hi) { unsigned r; asm volatile("v_cvt_pk_bf16_f32 %0, %1, %2" : "=v"(r) : "v"(lo), "v"(hi)); return r; }
typedef float f32x2 __attribute__((ext_vector_type(2)));
constexpr int EPI_M = 32768;
constexpr float EPI_C2 = 0.125f * 1.4426950408889634f;
__device__ __forceinline__ float sigm(float x) { return __builtin_amdgcn_rcpf(1.0f + __builtin_amdgcn_exp2f(-1.4426950408889634f * x)); }
__device__ __forceinline__ float bf_lo(unsigned u) { return __uint_as_float(u << 16); }
__device__ __forceinline__ float bf_hi(unsigned u) { return __uint_as_float(u & 0xffff0000u); }
__device__ __forceinline__ u32x4 pack8(const f32x4 a, const f32x4 b) { u32x4 w; w.x = cvt_pk_bf16(a[0], a[1]); w.y = cvt_pk_bf16(a[2], a[3]); w.z = cvt_pk_bf16(b[0], b[1]); w.w = cvt_pk_bf16(b[2], b[3]); return w; }

typedef __amdgpu_buffer_rsrc_t brsrc;
__device__ __forceinline__ brsrc mk_rsrc(const void* p, unsigned bytes) { return __builtin_amdgcn_make_buffer_rsrc(const_cast<void*>(p), 0, bytes, 0x00020000); }
__device__ __forceinline__ u32x4 bld16(brsrc r, unsigned voff, unsigned soff) { return __builtin_amdgcn_raw_buffer_load_b128(r, voff, soff, 0); }
__device__ __forceinline__ f32x4 bld16f(brsrc r, unsigned voff, unsigned soff) { return __builtin_bit_cast(f32x4, __builtin_amdgcn_raw_buffer_load_b128(r, voff, soff, 0)); }
__device__ __forceinline__ void bst16(brsrc r, unsigned voff, unsigned soff, u32x4 v) { __builtin_amdgcn_raw_buffer_store_b128(v, r, voff + soff, 0, 0); }
__device__ __forceinline__ void bst16f(brsrc r, unsigned voff, unsigned soff, f32x4 v) { __builtin_amdgcn_raw_buffer_store_b128(__builtin_bit_cast(u32x4, v), r, voff + soff, 0, 0); }
constexpr unsigned SZ_QKV = (unsigned)EPI_M * 1024u * 2u, SZ_G = (unsigned)EPI_M * 2048u * 2u, SZ_ROPE = (unsigned)EPI_M * 32u * 4u, SZ_X = (unsigned)EPI_M * 2048u * 4u, SZ_H = (unsigned)EPI_M * 8192u * 2u;

struct EpiInProj {
    static constexpr bool PERM = true, AFTER_DRAIN = false; static constexpr int MIDK = 0;
    bf16_t *Q, *Kb, *V, *U, *GA, *GS; const float* ropeC; const float* ropeS;
    __device__ __forceinline__ void mid(f32x4 (&)[2][2][4][2], const Unit&, int, int, int, int) const {}
    __device__ __forceinline__ void operator()(const f32x4 (&acc)[2][2][4][2], const Unit& u, int wr, int wc, int fr, int fq) const {
        const int pn = u.pn; const unsigned urow = (unsigned)(u.pm * BM + wr * 64);
        if (pn < 8) {
            const brsrc rb = mk_rsrc(pn < 4 ? Q : Kb, SZ_QKV), rc = mk_rsrc(ropeC, SZ_ROPE), rs = mk_rsrc(ropeS, SZ_ROPE); const float sc = pn < 4 ? EPI_C2 : 1.0f;
            const unsigned so = (urow * 1024u + (unsigned)((pn & 3) * BM + wc * 32)) * 2u, sr = (urow * 32u + 16u * (unsigned)(wc & 1)) * 4u;
            const unsigned lo = (unsigned)(fr * 1024 + 8 * fq) * 2u, lr = (unsigned)(fr * 32 + 4 * fq) * 4u;
#pragma unroll
            for (int ai = 0; ai < 2; ++ai)
#pragma unroll
                for (int m = 0; m < 4; ++m) { const unsigned dr = (unsigned)(ai * HALF + m * 16);
                    const f32x4 cs = bld16f(rc, lr, sr + dr * 128u), sn = bld16f(rs, lr, sr + dr * 128u);
#pragma unroll
                    for (int bj = 0; bj < 2; ++bj) { const f32x4 v0 = acc[ai][bj][m][0], v1 = acc[ai][bj][m][1]; f32x4 o0, o1;
                        o0[0] = (v0[0] * cs[0] - v0[1] * sn[0]) * sc; o0[1] = (v0[1] * cs[0] + v0[0] * sn[0]) * sc;
                        o0[2] = (v0[2] * cs[1] - v0[3] * sn[1]) * sc; o0[3] = (v0[3] * cs[1] + v0[2] * sn[1]) * sc;
                        o1[0] = (v1[0] * cs[2] - v1[1] * sn[2]) * sc; o1[1] = (v1[1] * cs[2] + v1[0] * sn[2]) * sc;
                        o1[2] = (v1[2] * cs[3] - v1[3] * sn[3]) * sc; o1[3] = (v1[3] * cs[3] + v1[2] * sn[3]) * sc;
                        bst16(rb, lo, so + (dr * 1024u + (unsigned)(bj * HALF)) * 2u, pack8(o0, o1)); }
                    if (m & 1) asm volatile("" ::: "memory"); }
        } else if (pn < 12) {
            const brsrc rb = mk_rsrc(V, SZ_QKV); const unsigned so = (urow * 1024u + (unsigned)((pn - 8) * BM + wc * 32)) * 2u, lo = (unsigned)(fr * 1024 + 8 * fq) * 2u;
#pragma unroll
            for (int ai = 0; ai < 2; ++ai)
#pragma unroll
                for (int m = 0; m < 4; ++m)
#pragma unroll
                    for (int bj = 0; bj < 2; ++bj) bst16(rb, lo, so + ((unsigned)(ai * HALF + m * 16) * 1024u + (unsigned)(bj * HALF)) * 2u, pack8(acc[ai][bj][m][0], acc[ai][bj][m][1]));
        } else if (pn < 16) {
            const brsrc rb = mk_rsrc(U, SZ_QKV); const unsigned ug = (unsigned)((pn - 12) * 16 + wc * 2), so = (ug * (unsigned)EPI_M + urow) * 32u;
            const unsigned lo = (unsigned)(((fq >> 1) * EPI_M + fr) * 16 + 8 * (fq & 1)) * 2u;
#pragma unroll
            for (int ai = 0; ai < 2; ++ai)
#pragma unroll
                for (int m = 0; m < 4; ++m)
#pragma unroll
                    for (int bj = 0; bj < 2; ++bj) bst16(rb, lo, so + ((unsigned)(8 * bj) * (unsigned)EPI_M + (unsigned)(ai * HALF + m * 16)) * 32u, pack8(acc[ai][bj][m][0], acc[ai][bj][m][1]));
        } else {
            const brsrc rb = mk_rsrc(pn < 24 ? GA : GS, SZ_G); const unsigned so = (urow * 2048u + (unsigned)(((pn - 16) & 7) * BM + wc * 32)) * 2u, lo = (unsigned)(fr * 2048 + 8 * fq) * 2u;
#pragma unroll
            for (int ai = 0; ai < 2; ++ai)
#pragma unroll
                for (int m = 0; m < 4; ++m)
#pragma unroll
                    for (int bj = 0; bj < 2; ++bj) { f32x4 v0 = acc[ai][bj][m][0], v1 = acc[ai][bj][m][1];
#pragma unroll
                        for (int e = 0; e < 4; ++e) { v0[e] = sigm(v0[e]); v1[e] = sigm(v1[e]); }
                        bst16(rb, lo, so + ((unsigned)(ai * HALF + m * 16) * 2048u + (unsigned)(bj * HALF)) * 2u, pack8(v0, v1)); }
        }
    }
};

struct EpiGlu {
    static constexpr bool PERM = true, AFTER_DRAIN = false; static constexpr int MIDK = 0;
    const bf16_t* G; bf16_t* AS;
    __device__ __forceinline__ void mid(f32x4 (&)[2][2][4][2], const Unit&, int, int, int, int) const {}
    __device__ __forceinline__ void operator()(const f32x4 (&acc)[2][2][4][2], const Unit& u, int wr, int wc, int fr, int fq) const {
        const unsigned urow = (unsigned)(u.pm * BM + wr * 64), ucol = (unsigned)(u.pn * BM + wc * 32);
        const brsrc rg = mk_rsrc(G, SZ_QKV), ro = mk_rsrc(AS, SZ_G);
        const unsigned sg = (urow * 1024u + ucol) * 2u, so = (urow * 2048u + 1024u + ucol) * 2u, lg = (unsigned)(fr * 1024 + 8 * fq) * 2u, lo = (unsigned)(fr * 2048 + 8 * fq) * 2u;
#pragma unroll
        for (int ai = 0; ai < 2; ++ai)
#pragma unroll
            for (int m = 0; m < 4; ++m) { const unsigned dr = (unsigned)(ai * HALF + m * 16);
#pragma unroll
                for (int bj = 0; bj < 2; ++bj) { const u32x4 gw = bld16(rg, lg, sg + (dr * 1024u + (unsigned)(bj * HALF)) * 2u);
                    f32x4 v0 = acc[ai][bj][m][0], v1 = acc[ai][bj][m][1];
                    v0[0] = bf_lo(gw.x) * sigm(v0[0]); v0[1] = bf_hi(gw.x) * sigm(v0[1]); v0[2] = bf_lo(gw.y) * sigm(v0[2]); v0[3] = bf_hi(gw.y) * sigm(v0[3]);
                    v1[0] = bf_lo(gw.z) * sigm(v1[0]); v1[1] = bf_hi(gw.z) * sigm(v1[1]); v1[2] = bf_lo(gw.w) * sigm(v1[2]); v1[3] = bf_hi(gw.w) * sigm(v1[3]);
                    bst16(ro, lo, so + (dr * 2048u + (unsigned)(bj * HALF)) * 2u, pack8(v0, v1)); }
                if (m & 1) asm volatile("" ::: "memory"); }
    }
};

struct EpiMerge {
    static constexpr bool PERM = true, AFTER_DRAIN = false; static constexpr int MIDK = 16;
    bf16_t* GA; const bf16_t* GS;
    __device__ __forceinline__ void mid(f32x4 (&acc)[2][2][4][2], const Unit& u, int wr, int wc, int fr, int fq) const {
        const brsrc ra = mk_rsrc(GA, SZ_G), rs = mk_rsrc(GS, SZ_G);
        const unsigned so = ((unsigned)(u.pm * BM + wr * 64) * 2048u + (unsigned)(u.pn * BM + wc * 32)) * 2u, lo = (unsigned)(fr * 2048 + 8 * fq) * 2u;
#pragma unroll
        for (int ai = 0; ai < 2; ++ai)
#pragma unroll
            for (int m = 0; m < 4; ++m) {
#pragma unroll
                for (int bj = 0; bj < 2; ++bj) { const unsigned o = so + ((unsigned)(ai * HALF + m * 16) * 2048u + (unsigned)(bj * HALF)) * 2u; const u32x4 a = bld16(ra, lo, o), s = bld16(rs, lo, o);
                    f32x4& v0 = acc[ai][bj][m][0]; f32x4& v1 = acc[ai][bj][m][1];
                    v0[0] *= bf_lo(a.x) * __builtin_amdgcn_rcpf(fmaxf(bf_lo(s.x), 1e-20f)); v0[1] *= bf_hi(a.x) * __builtin_amdgcn_rcpf(fmaxf(bf_hi(s.x), 1e-20f));
                    v0[2] *= bf_lo(a.y) * __builtin_amdgcn_rcpf(fmaxf(bf_lo(s.y), 1e-20f)); v0[3] *= bf_hi(a.y) * __builtin_amdgcn_rcpf(fmaxf(bf_hi(s.y), 1e-20f));
                    v1[0] *= bf_lo(a.z) * __builtin_amdgcn_rcpf(fmaxf(bf_lo(s.z), 1e-20f)); v1[1] *= bf_hi(a.z) * __builtin_amdgcn_rcpf(fmaxf(bf_hi(s.z), 1e-20f));
                    v1[2] *= bf_lo(a.w) * __builtin_amdgcn_rcpf(fmaxf(bf_lo(s.w), 1e-20f)); v1[3] *= bf_hi(a.w) * __builtin_amdgcn_rcpf(fmaxf(bf_hi(s.w), 1e-20f)); }
                if (m & 1) asm volatile("" ::: "memory"); }
    }
    __device__ __forceinline__ void operator()(const f32x4 (&acc)[2][2][4][2], const Unit& u, int wr, int wc, int fr, int fq) const {
        const brsrc ra = mk_rsrc(GA, SZ_G), rs = mk_rsrc(GS, SZ_G);
        const unsigned so = ((unsigned)(u.pm * BM + wr * 64) * 2048u + (unsigned)(u.pn * BM + wc * 32)) * 2u, lo = (unsigned)(fr * 2048 + 8 * fq) * 2u;
#pragma unroll
        for (int ai = 0; ai < 2; ++ai)
#pragma unroll
            for (int m = 0; m < 4; ++m) {
#pragma unroll
                for (int bj = 0; bj < 2; ++bj) { const unsigned o = so + ((unsigned)(ai * HALF + m * 16) * 2048u + (unsigned)(bj * HALF)) * 2u; const u32x4 s = bld16(rs, lo, o);
                    f32x4 v0 = acc[ai][bj][m][0], v1 = acc[ai][bj][m][1];
                    v0[0] *= fmaxf(bf_lo(s.x), 1e-20f); v0[1] *= fmaxf(bf_hi(s.x), 1e-20f); v0[2] *= fmaxf(bf_lo(s.y), 1e-20f); v0[3] *= fmaxf(bf_hi(s.y), 1e-20f);
                    v1[0] *= fmaxf(bf_lo(s.z), 1e-20f); v1[1] *= fmaxf(bf_hi(s.z), 1e-20f); v1[2] *= fmaxf(bf_lo(s.w), 1e-20f); v1[3] *= fmaxf(bf_hi(s.w), 1e-20f);
                    bst16(ra, lo, o, pack8(v0, v1)); }
                if (m & 1) asm volatile("" ::: "memory"); }
    }
};

struct EpiResF32 {
    static constexpr bool PERM = false, AFTER_DRAIN = false; static constexpr int MIDK = 0;
    const float* xin; float* out; float alpha;
    __device__ __forceinline__ void mid(f32x4 (&)[2][2][4][2], const Unit&, int, int, int, int) const {}
    __device__ __forceinline__ void operator()(const f32x4 (&acc)[2][2][4][2], const Unit& u, int wr, int wc, int fr, int fq) const {
        const brsrc ri = mk_rsrc(xin, SZ_X), ro = mk_rsrc(out, SZ_X);
        const unsigned so = ((unsigned)(u.pm * BM + wr * 64) * 2048u + (unsigned)(u.pn * BM + wc * 32)) * 4u, lo = (unsigned)(fr * 2048 + 4 * fq) * 4u;
#pragma unroll
        for (int ai = 0; ai < 2; ++ai)
#pragma unroll
            for (int m = 0; m < 4; ++m) {
#pragma unroll
                for (int bj = 0; bj < 2; ++bj)
#pragma unroll
                    for (int n = 0; n < 2; ++n) { const unsigned o = so + ((unsigned)(ai * HALF + m * 16) * 2048u + (unsigned)(bj * HALF + n * 16)) * 4u; const f32x4 xv = bld16f(ri, lo, o); bst16f(ro, lo, o, xv * alpha + acc[ai][bj][m][n]); }
                if (m & 1) asm volatile("" ::: "memory"); }
    }
};

struct EpiRelu2 {
    static constexpr bool PERM = true, AFTER_DRAIN = false; static constexpr int MIDK = 0;
    bf16_t* H;
    __device__ __forceinline__ void mid(f32x4 (&)[2][2][4][2], const Unit&, int, int, int, int) const {}
    __device__ __forceinline__ void operator()(const f32x4 (&acc)[2][2][4][2], const Unit& u, int wr, int wc, int fr, int fq) const {
        const brsrc rb = mk_rsrc(H, SZ_H); const unsigned so = ((unsigned)(u.pm * BM + wr * 64) * 8192u + (unsigned)(u.pn * BM + wc * 32)) * 2u, lo = (unsigned)(fr * 8192 + 8 * fq) * 2u;
#pragma unroll
        for (int ai = 0; ai < 2; ++ai)
#pragma unroll
            for (int m = 0; m < 4; ++m)
#pragma unroll
                for (int bj = 0; bj < 2; ++bj) { f32x4 v0 = acc[ai][bj][m][0], v1 = acc[ai][bj][m][1];
#pragma unroll
                    for (int e = 0; e < 4; ++e) { const float a = fmaxf(v0[e], 0.f), b = fmaxf(v1[e], 0.f); v0[e] = a * a; v1[e] = b * b; }
                    bst16(rb, lo, so + ((unsigned)(ai * HALF + m * 16) * 8192u + (unsigned)(bj * HALF)) * 2u, pack8(v0, v1)); }
    }
};
template <class Epi, class Sched, bool ALIGN_EPI = false, bool SP2 = false, bool DRAINALL = false>
__device__ __forceinline__ void gemm_phase(PG8_LAS unsigned char* lds, const Gemm g, const Sched& S, const Epi& E) {
    const int tid = opaque_tid(), wid = __builtin_amdgcn_readfirstlane(tid >> 6), lane = tid & 63, wr = wid >> 2, wc = wid & 3, fr = lane & 15, fq = lane >> 4;
    const int K = g.K, nt = K / BK;
    unsigned voffA[2], voffB[2];
#pragma unroll
    for (int i = 0; i < 2; ++i) { int R, C; stage_rc(tid * 16 + i * 8192, R, C); const int Rb = Epi::PERM ? ((R & ~31) + perm32(R & 31)) : R;
        voffA[i] = (unsigned)(R * K + C) * 2u; voffB[i] = (unsigned)(Rb * K + C) * 2u; }
    const size_t kstep = (size_t)(BK * 2);
    const size_t hstep = (size_t)HALF * K * 2;
    const size_t tstep = 2 * hstep;
    const unsigned ldsw = (unsigned)wid * 1024u;
    const int aoff = lds_byte(wr * 64 + fr, fq * 8), boff = lds_byte(wc * 32 + fr, fq * 8);
#define PG8_SA(b, h) (((b) * 2 + (h)) * HTB)
#define PG8_SB(b, h) ((4 + (b) * 2 + (h)) * HTB)
#define PG8_STAGE(bufoff, gbase, voff) do { _Pragma("unroll") for (int _i = 0; _i < 2; ++_i) \
        __builtin_amdgcn_global_load_lds((const unsigned*)((const char*)(gbase) + (voff)[_i]), (PG8_LAS unsigned*)(lds + (bufoff) + ldsw + _i * 8192), 16, 0, 0); } while (0)
#define PG8_LDA(dst, b, h) do { _Pragma("unroll") for (int m = 0; m < 4; ++m) _Pragma("unroll") for (int k = 0; k < 2; ++k) dst[m][k] = *(const PG8_LAS bf16x8*)(lds + PG8_SA(b, h) + aoff + m * 2048 + k * 1024); } while (0)
#define PG8_LDB(dst, b, h) do { _Pragma("unroll") for (int n = 0; n < 2; ++n) _Pragma("unroll") for (int k = 0; k < 2; ++k) dst[n][k] = *(const PG8_LAS bf16x8*)(lds + PG8_SB(b, h) + boff + n * 2048 + k * 1024); } while (0)
#define PG8_MMA(ai, bj, At, Bt) do { __builtin_amdgcn_s_setprio(1); _Pragma("unroll") for (int m = 0; m < 4; ++m) _Pragma("unroll") for (int n = 0; n < 2; ++n) _Pragma("unroll") for (int k = 0; k < 2; ++k) \
        acc[ai][bj][m][n] = __builtin_amdgcn_mfma_f32_16x16x32_bf16(Bt[n][k], At[m][k], acc[ai][bj][m][n], 0, 0, 0); __builtin_amdgcn_s_setprio(0); } while (0)
#define PG8_WAIT_V(n) do { if constexpr (DRAINALL) asm volatile("s_waitcnt vmcnt(0)" ::: "memory"); else asm volatile("s_waitcnt vmcnt(" #n ")" ::: "memory"); } while (0)
#define PG8_WAIT_L(n) asm volatile("s_waitcnt lgkmcnt(" #n ")" ::: "memory")
#define PG8_BAR __builtin_amdgcn_s_barrier()
#define PG8_SCHED __builtin_amdgcn_sched_barrier(0)
    Unit cur, nxt; int ui = 0;
    if (!S.next(0, cur)) return;
    f32x4 acc[2][2][4][2];
#pragma unroll
    for (int a = 0; a < 2; ++a)
#pragma unroll
        for (int b = 0; b < 2; ++b)
#pragma unroll
            for (int m = 0; m < 4; ++m)
#pragma unroll
                for (int n = 0; n < 2; ++n) acc[a][b][m][n] = (f32x4){0.f, 0.f, 0.f, 0.f};
    bf16x8 At[4][2], B0[2][2], B1[2][2];
    const char* cA = (const char*)g.A + (size_t)cur.pm * tstep; const char* cB = (const char*)g.Bt + (size_t)cur.pn * tstep;
    S.a_ready(cur);
    if constexpr (SP2) {
        PG8_STAGE(PG8_SB(0, 0), cB, voffB); PG8_STAGE(PG8_SB(0, 1), cB + hstep, voffB); PG8_STAGE(PG8_SA(0, 0), cA, voffA); PG8_STAGE(PG8_SA(0, 1), cA + hstep, voffA);
        if (wr == 1) PG8_BAR;
        PG8_WAIT_V(2); PG8_BAR;
        PG8_STAGE(PG8_SB(1, 0), cB + kstep, voffB); PG8_STAGE(PG8_SA(1, 0), cA + kstep, voffA); PG8_STAGE(PG8_SB(1, 1), cB + hstep + kstep, voffB);
        PG8_WAIT_V(6); PG8_BAR;
    } else {
        PG8_STAGE(PG8_SB(0, 0), cB, voffB); PG8_STAGE(PG8_SA(0, 0), cA, voffA); PG8_STAGE(PG8_SB(0, 1), cB + hstep, voffB); PG8_STAGE(PG8_SA(0, 1), cA + hstep, voffA);
        if (wr == 1) PG8_BAR;
        PG8_WAIT_V(4); PG8_BAR;
        PG8_STAGE(PG8_SB(1, 0), cB + kstep, voffB); PG8_STAGE(PG8_SA(1, 0), cA + kstep, voffA); PG8_STAGE(PG8_SB(1, 1), cB + hstep + kstep, voffB);
        PG8_WAIT_V(6); PG8_BAR;
    }
    for (;;) {
        const bool has_next = S.next(ui + 1, nxt);
        const char* nA = has_next ? (const char*)g.A + (size_t)nxt.pm * tstep : cA; const char* nB = has_next ? (const char*)g.Bt + (size_t)nxt.pn * tstep : cB;
        for (int t = 0; t < nt; t += 2) {
            const bool last = (t == nt - 2);
            const char* a1 = cA + (size_t)(t + 1) * kstep;
            const char* a2 = last ? nA : cA + (size_t)(t + 2) * kstep; const char* b2 = last ? nB : cB + (size_t)(t + 2) * kstep;
            const char* a3 = a2 + kstep; const char* b3 = b2 + kstep;
            if (last && has_next) S.a_ready(nxt);
            if constexpr (SP2) {
            PG8_LDB(B0, 0, 0); PG8_LDB(B1, 0, 1); PG8_SCHED; PG8_LDA(At, 0, 0); PG8_STAGE(PG8_SA(1, 1), a1 + hstep, voffA);
            PG8_WAIT_V(8); PG8_WAIT_L(0); PG8_BAR; PG8_MMA(0, 0, At, B0); PG8_MMA(0, 1, At, B1); PG8_BAR; PG8_SCHED;
            PG8_LDA(At, 0, 1); PG8_STAGE(PG8_SB(0, 0), b2, voffB); PG8_STAGE(PG8_SB(0, 1), b2 + hstep, voffB); PG8_STAGE(PG8_SA(0, 0), a2, voffA);
            PG8_WAIT_V(8); PG8_WAIT_L(0); PG8_BAR; PG8_MMA(1, 0, At, B0); PG8_MMA(1, 1, At, B1); PG8_BAR; PG8_SCHED;
            PG8_LDB(B0, 1, 0); PG8_LDB(B1, 1, 1); PG8_SCHED; PG8_LDA(At, 1, 0); PG8_STAGE(PG8_SA(0, 1), a2 + hstep, voffA);
            PG8_WAIT_V(8); PG8_WAIT_L(0); PG8_BAR; PG8_MMA(0, 0, At, B0); PG8_MMA(0, 1, At, B1); PG8_BAR; PG8_SCHED;
            PG8_LDA(At, 1, 1); PG8_STAGE(PG8_SB(1, 0), b3, voffB); PG8_STAGE(PG8_SB(1, 1), b3 + hstep, voffB); PG8_STAGE(PG8_SA(1, 0), a3, voffA);
            PG8_WAIT_V(8); PG8_WAIT_L(0); PG8_BAR; PG8_MMA(1, 0, At, B0); PG8_MMA(1, 1, At, B1); PG8_BAR; PG8_SCHED;
            } else {
            PG8_LDB(B0, 0, 0); PG8_SCHED; PG8_LDA(At, 0, 0); PG8_STAGE(PG8_SA(1, 1), a1 + hstep, voffA);
            PG8_WAIT_L(8); PG8_BAR; PG8_WAIT_L(0); PG8_MMA(0, 0, At, B0); PG8_BAR; PG8_SCHED;
            PG8_LDB(B1, 0, 1); PG8_STAGE(PG8_SB(0, 0), b2, voffB);
            PG8_BAR; PG8_WAIT_L(0); PG8_MMA(0, 1, At, B1); PG8_BAR;
            PG8_LDA(At, 0, 1); PG8_STAGE(PG8_SA(0, 0), a2, voffA);
            PG8_BAR; PG8_WAIT_L(0); PG8_MMA(1, 0, At, B0); PG8_BAR; PG8_SCHED;
            PG8_STAGE(PG8_SB(0, 1), b2 + hstep, voffB);
            PG8_WAIT_V(6); PG8_BAR; PG8_MMA(1, 1, At, B1); PG8_BAR;
            PG8_LDB(B0, 1, 0); PG8_SCHED; PG8_LDA(At, 1, 0); PG8_STAGE(PG8_SA(0, 1), a2 + hstep, voffA);
            PG8_WAIT_L(8); PG8_BAR; PG8_WAIT_L(0); PG8_MMA(0, 0, At, B0); PG8_BAR; PG8_SCHED;
            PG8_LDB(B1, 1, 1); PG8_STAGE(PG8_SB(1, 0), b3, voffB);
            PG8_BAR; PG8_WAIT_L(0); PG8_MMA(0, 1, At, B1); PG8_BAR;
            PG8_LDA(At, 1, 1); PG8_STAGE(PG8_SA(1, 0), a3, voffA);
            PG8_BAR; PG8_WAIT_L(0); PG8_MMA(1, 0, At, B0); PG8_BAR; PG8_SCHED;
            PG8_STAGE(PG8_SB(1, 1), b3 + hstep, voffB);
            PG8_WAIT_V(6); PG8_BAR; PG8_MMA(1, 1, At, B1); PG8_BAR;
            }
            if constexpr (Epi::MIDK > 0) { if (t + 2 == Epi::MIDK) E.mid(acc, cur, wr, wc, fr, fq); }
        }
        if constexpr (ALIGN_EPI) { if (wr == 0) PG8_BAR; }
        if constexpr (!Epi::AFTER_DRAIN) { E(acc, cur, wr, wc, fr, fq); S.done(cur); }
        if (!has_next) break;
#pragma unroll
        for (int a = 0; a < 2; ++a)
#pragma unroll
            for (int b = 0; b < 2; ++b)
#pragma unroll
                for (int m = 0; m < 4; ++m)
#pragma unroll
                    for (int n = 0; n < 2; ++n) acc[a][b][m][n] = (f32x4){0.f, 0.f, 0.f, 0.f};
        cur = nxt; cA = nA; cB = nB; ++ui;
        if constexpr (ALIGN_EPI) { if (wr == 1) PG8_BAR; }
    }
    PG8_WAIT_V(0);
    if constexpr (!ALIGN_EPI) { if (wr == 0) PG8_BAR; }
    PG8_BAR;
    if constexpr (Epi::AFTER_DRAIN) { E.fused(acc, cur, wr, wc, fr, fq, lds, wid, lane); S.done(cur); }
#undef PG8_SA
#undef PG8_SB
#undef PG8_STAGE
#undef PG8_LDA
#undef PG8_LDB
#undef PG8_MMA
#undef PG8_WAIT_V
#undef PG8_WAIT_L
#undef PG8_BAR
#undef PG8_SCHED
}
}
#include <hip/hip_bf16.h>
#include <cmath>
namespace attn_body {
using bf16=__hip_bfloat16;
using bf16x8=__attribute__((ext_vector_type(8)))short;
using s16x4=__attribute__((ext_vector_type(4)))short;
using f32x16=__attribute__((ext_vector_type(16)))float;
using u32x4=__attribute__((ext_vector_type(4)))unsigned;
constexpr int SEQ=8192,D=64,DM=1024,OPITCH=2048;
constexpr int NW=8,QBLK=32,QB=QBLK*NW,KVBLK=64,NQB=SEQ/QB;
constexpr int ATTN_UNIT_ROWS=QB;
__device__ __forceinline__ int crow(int r,int hi){return (r&3)+8*(r>>2)+4*hi;}
#define SBAR() __builtin_amdgcn_sched_barrier(0)
__device__ __forceinline__ void cmask(f32x16&p0,f32x16&p1,int jb,int qrel,int hi){
  const float NEG=-INFINITY; int kb=64*jb+4*hi;
  #pragma unroll
  for(int r=0;r<16;++r){int kv=kb+(r&3)+8*(r>>2); if(kv>qrel)p0[r]=NEG; if(kv+32>qrel)p1[r]=NEG;}
}

constexpr int NSLOT=3, SLOTB=8192;
constexpr int LDS_K=0, LDS_V=NSLOT*SLOTB, LDS_WS=LDS_V+NSLOT*2*SLOTB, LDS_OST=LDS_WS+NW*64*4, LDS_BYTES=LDS_OST+NW*4096;
constexpr float C2=0.125f*1.4426950408889634f;
__device__ __forceinline__ void glds16(const void*gsrc,unsigned lds_dst){unsigned keep;
  asm volatile("s_mov_b32 %0, m0\n\ts_mov_b32 m0, %2\n\ts_nop 0\n\tglobal_load_lds_dwordx4 %1, off\n\ts_mov_b32 m0, %0":"=&s"(keep):"v"(gsrc),"s"(lds_dst):"memory");}
__device__ __forceinline__ float max3f(float a,float b,float c){float r;asm("v_max3_f32 %0, %1, %2, %3":"=v"(r):"v"(a),"v"(b),"v"(c));return r;}
__device__ __forceinline__ float max2f(float a,float b){float r;asm("v_max_f32_e32 %0, %1, %2":"=v"(r):"v"(a),"v"(b));return r;}
__device__ __forceinline__ float fadd_s(float a,float b){float r;asm("v_add_f32_e32 %0, %1, %2":"=v"(r):"v"(a),"v"(b));return r;}
__device__ __forceinline__ float fsub_s(float a,float b){float r;asm("v_sub_f32_e32 %0, %1, %2":"=v"(r):"v"(a),"v"(b));return r;}
typedef float f32x2_t __attribute__((ext_vector_type(2))); typedef __bf16 bf16x2_t __attribute__((ext_vector_type(2)));
__device__ __forceinline__ unsigned cvtpk_s(float lo,float hi){f32x2_t v={lo,hi};bf16x2_t b=__builtin_convertvector(v,bf16x2_t);return __builtin_bit_cast(unsigned,b);}
#define WAIT_BAR(N) asm volatile("s_waitcnt vmcnt(" #N ") lgkmcnt(0)\n\ts_barrier":::"memory")

__device__ __forceinline__ void qkt(f32x16&p0,f32x16&p1,const char*Kslot,const bf16x8*qr,const f32x16&negm,int r32,int hi){
  const char*kb=Kslot+hi*1024+r32*16;
  #pragma unroll
  for(int d0=0;d0<4;++d0){
    const bf16x8 b0=*reinterpret_cast<const bf16x8*>(kb+d0*2048);
    const bf16x8 b1=*reinterpret_cast<const bf16x8*>(kb+d0*2048+512);
    if(d0==0){p0=__builtin_amdgcn_mfma_f32_32x32x16_bf16(b0,qr[0],negm,0,0,0);p1=__builtin_amdgcn_mfma_f32_32x32x16_bf16(b1,qr[0],negm,0,0,0);}
    else{p0=__builtin_amdgcn_mfma_f32_32x32x16_bf16(b0,qr[d0],p0,0,0,0);p1=__builtin_amdgcn_mfma_f32_32x32x16_bf16(b1,qr[d0],p1,0,0,0);}}
}
typedef __attribute__((address_space(3))) const char* lds_cptr;
typedef short v4i16_t __attribute__((ext_vector_type(4)));
__device__ __forceinline__ void kload8(bf16x8*kf,lds_cptr kp){
  kf[0]=*(const __attribute__((address_space(3))) bf16x8*)(kp);      kf[1]=*(const __attribute__((address_space(3))) bf16x8*)(kp+512);
  kf[2]=*(const __attribute__((address_space(3))) bf16x8*)(kp+2048); kf[3]=*(const __attribute__((address_space(3))) bf16x8*)(kp+2560);
  kf[4]=*(const __attribute__((address_space(3))) bf16x8*)(kp+4096); kf[5]=*(const __attribute__((address_space(3))) bf16x8*)(kp+4608);
  kf[6]=*(const __attribute__((address_space(3))) bf16x8*)(kp+6144); kf[7]=*(const __attribute__((address_space(3))) bf16x8*)(kp+6656);
}
__device__ __forceinline__ void kload2(bf16x8*kf,lds_cptr kp,int j){ kf[2*j]=*(const __attribute__((address_space(3))) bf16x8*)(kp+j*2048); kf[2*j+1]=*(const __attribute__((address_space(3))) bf16x8*)(kp+j*2048+512); }
__device__ __forceinline__ s16x4 vtr(lds_cptr p){ return __builtin_bit_cast(s16x4,__builtin_amdgcn_ds_read_tr16_b64_v4i16((__attribute__((address_space(3))) v4i16_t*)p)); }
__device__ __forceinline__ float rowmax(const f32x16&p0,const f32x16&p1){
  float a=max3f(p0[0],p0[1],p1[0]),b=max3f(p0[2],p0[3],p1[1]);a=max3f(a,p1[2],p1[3]);
  #pragma unroll
  for(int r=4;r<16;r+=4){a=max3f(a,p0[r],p0[r+1]);b=max3f(b,p0[r+2],p0[r+3]);a=max3f(a,p1[r],p1[r+1]);b=max3f(b,p1[r+2],p1[r+3]);}
  const float m=max2f(a,b);
  auto rr=__builtin_amdgcn_permlane32_swap(__float_as_uint(m),__float_as_uint(m),false,false);
  return max2f(__uint_as_float(rr[0]),__uint_as_float(rr[1]));
}
__device__ __forceinline__ void pv(f32x16*o,int vb,bf16x8 pa0,bf16x8 pa1,bf16x8 pa2,bf16x8 pa3){
  #pragma unroll
  for(int d0=0;d0<4;++d0){s16x4 lo[4],hi[4];
    #pragma unroll
    for(int ks=0;ks<4;++ks){
      asm volatile("ds_read_b64_tr_b16 %0,%1 offset:%c2":"=&v"(lo[ks]):"v"(vb),"i"(d0*4096+ks*1024):"memory");
      asm volatile("ds_read_b64_tr_b16 %0,%1 offset:%c2":"=&v"(hi[ks]):"v"(vb),"i"(d0*4096+ks*1024+512):"memory");}
    asm volatile("s_waitcnt lgkmcnt(0)":::"memory");SBAR();
    #define PK(k) (bf16x8){lo[k][0],lo[k][1],lo[k][2],lo[k][3],hi[k][0],hi[k][1],hi[k][2],hi[k][3]}
    o[d0]=__builtin_amdgcn_mfma_f32_32x32x16_bf16(pa0,PK(0),o[d0],0,0,0);
    o[d0]=__builtin_amdgcn_mfma_f32_32x32x16_bf16(pa1,PK(1),o[d0],0,0,0);
    o[d0]=__builtin_amdgcn_mfma_f32_32x32x16_bf16(pa2,PK(2),o[d0],0,0,0);
    o[d0]=__builtin_amdgcn_mfma_f32_32x32x16_bf16(pa3,PK(3),o[d0],0,0,0);
    #undef PK
  }
}

#ifndef ATTN_STORE16
#define ATTN_STORE16(p,v) (*(u32x4*)(p)=(v))
#endif
template<int THRL> __device__ __forceinline__ void attn_unit(int b,int qcol,int vcol,int ocol,int qb,const bf16*Q,const bf16*__restrict__ K,const bf16*__restrict__ V,bf16*O,char*shm){
  const int tid=opaque_tid(),lane=tid&63,r32=lane&31,hi=lane>>5; const int wid=__builtin_amdgcn_readfirstlane(tid>>6);
  const long rowbase=(long)b*SEQ; const int q0=qb*QB;
  const bf16*Qw=Q+(rowbase+q0+wid*QBLK)*DM+qcol;
  const bf16*Kh=K+rowbase*DM+qcol,*Vh=V+rowbase*DM+vcol;
  const unsigned lds0=(unsigned)(uintptr_t)shm;
  float*wsf=(float*)(shm+LDS_WS)+wid*64;
  const bf16*ksrc=Kh+(long)lane*DM+wid*8;
  const bf16*vsrc=Vh+(long)(16*(wid&3)+(lane>>2))*DM+(wid>>2)*32+(lane&3)*8;
  const unsigned kdst=lds0+LDS_K+wid*1024, vdst=lds0+LDS_V+wid*1024;
  #define DMA_K(t,slot) glds16(ksrc+(long)(t)*KVBLK*DM,(unsigned)__builtin_amdgcn_readfirstlane(kdst+(slot)))
  #define DMA_V(t,slot) do{ glds16(vsrc+(long)(t)*KVBLK*DM,(unsigned)__builtin_amdgcn_readfirstlane(vdst+2*(slot))); glds16(vsrc+(long)(t)*KVBLK*DM+64,(unsigned)__builtin_amdgcn_readfirstlane(vdst+2*(slot)+8192)); }while(0)
  const int vb0=(int)(lds0+LDS_V)+((lane>>4)&1)*32+(lane&3)*8+(4*hi+((lane&15)>>2))*64;
  const char*Kbase=shm+LDS_K; bf16x8 kf[8];
  const lds_cptr shm3=(lds_cptr)shm; const lds_cptr kp0=shm3+LDS_K+hi*1024+r32*16; const lds_cptr vp0=shm3+LDS_V+((lane>>4)&1)*32+(lane&3)*8+(4*hi+((lane&15)>>2))*64;
  const int NT=(q0+QB)/KVBLK;
  DMA_K(0,0);DMA_V(0,0);DMA_K(1,SLOTB);
  bf16x8 qr[4];
  #pragma unroll
  for(int d0=0;d0<4;++d0)qr[d0]=*reinterpret_cast<const bf16x8*>(&Qw[(long)r32*DM+d0*16+hi*8]);
  float mhat=0.f,l_reg=0.f;f32x16 o[4];o[0]=f32x16{};o[1]=f32x16{};o[2]=f32x16{};o[3]=f32x16{};const f32x16 ZC=f32x16{};
  const int qrel=wid*QBLK+r32;
  #define CMASK(P0,P1,t) do{int jb_=(t)-(NT-4); if(jb_>=0)cmask(P0,P1,jb_,qrel,hi);}while(0)
  bool resc=false;
  #define START(P0,P1) do{ const float rm=rowmax(P0,P1); resc=false; \
    { const float dl=rm; mhat=fadd_s(mhat,dl); \
      _Pragma("unroll") for(int r=0;r<16;++r){P0[r]=fsub_s(P0[r],dl);P1[r]=fsub_s(P1[r],dl);} } \
    _Pragma("unroll") for(int r=0;r<16;++r)P0[r]=__builtin_amdgcn_exp2f(P0[r]); }while(0)
  #define RESC() do{ if(resc){ asm volatile("s_waitcnt lgkmcnt(0)":::"memory"); \
      _Pragma("unroll") for(int d_=0;d_<4;++d_) _Pragma("unroll") for(int r=0;r<16;++r)o[d_][r]*=wsf[crow(r,hi)]; } }while(0)
  f32x16 pA0,pA1,pB0,pB1;
  int sl_prev=0,sl_cur=0,sl_next=SLOTB;
  #define ROT() do{sl_prev=sl_cur;sl_cur=sl_next;sl_next=(sl_next==(NSLOT-1)*SLOTB)?0:sl_next+SLOTB;}while(0)
  DMA_K(2,2*SLOTB);
  WAIT_BAR(4);
  qkt(pA0,pA1,Kbase,qr,ZC,r32,hi);asm volatile("s_nop 15\n\ts_nop 7":"+v"(pA0),"+v"(pA1));CMASK(pA0,pA1,0);
  START(pA0,pA1);
  _Pragma("unroll") for(int r=0;r<16;++r)pA1[r]=__builtin_amdgcn_exp2f(pA1[r]);
  WAIT_BAR(0);
  DMA_K(3,0);DMA_V(1,SLOTB);
  ROT();
  kload8(kf,kp0+sl_cur);
  WAIT_BAR(3);
  s16x4 vlo[8],vhi[8]; u32x4 pw0,pw1,pw2,pw3;
  #define PKW(P,B) cvtpk_s(P[B],P[B+1])
  #define PAF(k) __builtin_bit_cast(bf16x8,pw##k)
  #define VFR(i) (bf16x8){vlo[i][0],vlo[i][1],vlo[i][2],vlo[i][3],vhi[i][0],vhi[i][1],vhi[i][2],vhi[i][3]}
  #define PIN(x) asm volatile("":"+v"(x))
  #define MX3(a,b,c) __builtin_fmaxf(__builtin_fmaxf((a),(b)),(c))
  #define GAPA(MF,A0,A1,A2,A3,W0,W1,PW) do{ MF; sacc+=A0; sacc+=A1; sacc+=A2; sacc+=A3; PIN(sacc); W0; W1; PIN(PW); SBAR(); }while(0)
  #define EX(v) __builtin_amdgcn_exp2f(v)
  #define GAPB2(MF,RD,X,B) do{ MF; RD; X[B]=EX(X[B]-mhat); X[B+1]=EX(X[B+1]-mhat); PIN(X); SBAR(); }while(0)
  #define VRD(i) do{ vlo[i]=vtr(vp_+(((i)>>2)*4096+((i)&3)*1024)); vhi[i]=vtr(vp_+(((i)>>2)*4096+((i)&3)*1024+512)); }while(0)
  #define VRD2(i) do{ vlo[i]=vtr(vp_+((2+((i)>>2))*4096+((i)&3)*1024)); vhi[i]=vtr(vp_+((2+((i)>>2))*4096+((i)&3)*1024+512)); }while(0)
  #define NORD do{}while(0)
  #define KRD(G,j) do{ if(G){ kload2(kf,kp0+sl_next,j); SBAR(); } }while(0)
  #define MF32(a,b,c) __builtin_amdgcn_mfma_f32_32x32x16_bf16(a,b,c,0,0,0)
  #define STEP(C0,C1,P0,P1,t,GK,GV,GL) do{ SBAR(); \
    const lds_cptr vp_=vp0+2*sl_prev; \
    VRD(0); SBAR(); float sacc=(P0[0]+P0[1]); \
    GAPA(C0=MF32(kf[0],qr[0],ZC), P0[2],P0[3],P0[4],P0[5],     pw0[0]=PKW(P0,0), pw0[1]=PKW(P0,2), pw0); \
    VRD(4); SBAR(); GAPA(C1=MF32(kf[1],qr[0],ZC), P0[6],P0[7],P0[8],P0[9],     pw0[2]=PKW(P0,4), pw0[3]=PKW(P0,6), pw0); \
    VRD(1); SBAR(); GAPA(C0=MF32(kf[2],qr[1],C0),   P0[10],P0[11],P0[12],P0[13], pw1[0]=PKW(P0,8), pw1[1]=PKW(P0,10), pw1); \
    VRD(5); SBAR(); GAPA(C1=MF32(kf[3],qr[1],C1),   P0[14],P0[15],P1[0],P1[1],   pw1[2]=PKW(P0,12),pw1[3]=PKW(P0,14), pw1); \
    VRD(2); SBAR(); GAPA(C0=MF32(kf[4],qr[2],C0),   P1[2],P1[3],P1[4],P1[5],     pw2[0]=PKW(P1,0), pw2[1]=PKW(P1,2), pw2); \
    VRD(6); SBAR(); GAPA(C1=MF32(kf[5],qr[2],C1),   P1[6],P1[7],P1[8],P1[9],     pw2[2]=PKW(P1,4), pw2[3]=PKW(P1,6), pw2); \
    VRD(3); SBAR(); GAPA(C0=MF32(kf[6],qr[3],C0),   P1[10],P1[11],P1[12],P1[13], pw3[0]=PKW(P1,8), pw3[1]=PKW(P1,10), pw3); \
    VRD(7); SBAR(); GAPA(C1=MF32(kf[7],qr[3],C1),   P1[14],P1[15],0.f,0.f,       pw3[2]=PKW(P1,12),pw3[3]=PKW(P1,14), pw3); \
    l_reg+=sacc; \
    if(GK){DMA_K((t)+3,sl_cur);} if(GV){DMA_V((t)+1,sl_next);} \
    CMASK(C0,C1,t); \
    { float a=MX3(C0[0],C0[1],C1[0]),b=MX3(C0[2],C0[3],C1[1]); a=MX3(a,C1[2],C1[3]); \
      _Pragma("unroll") for(int r=4;r<16;r+=4){a=MX3(a,C0[r],C0[r+1]);b=MX3(b,C0[r+2],C0[r+3]);a=MX3(a,C1[r],C1[r+1]);b=MX3(b,C1[r+2],C1[r+3]);} \
      float rm=__builtin_fmaxf(a,b); { auto rr=__builtin_amdgcn_permlane32_swap(__float_as_uint(rm),__float_as_uint(rm),false,false); rm=__builtin_fmaxf(__uint_as_float(rr[0]),__uint_as_float(rr[1])); } \
      resc=false; \
      rm-=mhat; \
      if(__builtin_expect(__any(rm>(float)THRL),0)){ const float dl=__builtin_fmaxf(rm,0.f); mhat+=dl; \
        const float f=__builtin_amdgcn_exp2f(-dl); l_reg*=f; if(hi==0)wsf[r32]=f; resc=true; } } \
    SBAR(); \
      \
    GAPB2(o[0]=MF32(PAF(0),VFR(0),o[0]), VRD2(0), C0,0); \
    GAPB2(o[1]=MF32(PAF(0),VFR(4),o[1]), VRD2(4), C0,2); \
    GAPB2(o[0]=MF32(PAF(1),VFR(1),o[0]), VRD2(1), C0,4); \
    GAPB2(o[1]=MF32(PAF(1),VFR(5),o[1]), VRD2(5), C0,6); \
    GAPB2(o[0]=MF32(PAF(2),VFR(2),o[0]), VRD2(2), C0,8); \
    GAPB2(o[1]=MF32(PAF(2),VFR(6),o[1]), VRD2(6), C0,10); \
    GAPB2(o[0]=MF32(PAF(3),VFR(3),o[0]), VRD2(3), C0,12); \
    GAPB2(o[1]=MF32(PAF(3),VFR(7),o[1]), VRD2(7), C0,14); \
      \
    GAPB2(o[2]=MF32(PAF(0),VFR(0),o[2]), NORD, C1,0); \
    GAPB2(o[3]=MF32(PAF(0),VFR(4),o[3]), NORD, C1,2); \
    KRD(GL,0); GAPB2(o[2]=MF32(PAF(1),VFR(1),o[2]), NORD, C1,4); \
    KRD(GL,1); GAPB2(o[3]=MF32(PAF(1),VFR(5),o[3]), NORD, C1,6); \
    KRD(GL,2); GAPB2(o[2]=MF32(PAF(2),VFR(2),o[2]), NORD, C1,8); \
    KRD(GL,3); GAPB2(o[3]=MF32(PAF(2),VFR(6),o[3]), NORD, C1,10); \
    GAPB2(o[2]=MF32(PAF(3),VFR(3),o[2]), NORD, C1,12); \
    GAPB2(o[3]=MF32(PAF(3),VFR(7),o[3]), NORD, C1,14); \
    }while(0)
  int t=1;
  #undef CMASK
  #define CMASK(P0,P1,t) do{}while(0)
  for(;t+5<NT;t+=2){
    STEP(pB0,pB1,pA0,pA1,t,true,true,true);     WAIT_BAR(3); RESC(); ROT();
    STEP(pA0,pA1,pB0,pB1,t+1,true,true,true);   WAIT_BAR(3); RESC(); ROT();
  }
  #undef CMASK
  #define CMASK(P0,P1,t) do{int jb_=(t)-(NT-4); if(jb_>=0)cmask(P0,P1,jb_,qrel,hi);}while(0)
  #define ENDW(tt) do{ if((tt)+3<NT){WAIT_BAR(3);} else if((tt)+2<NT){WAIT_BAR(2);} else {WAIT_BAR(0);} }while(0)
  for(;t+1<NT;t+=2){
    STEP(pB0,pB1,pA0,pA1,t,(t+3<NT),(t+1<NT),(t+1<NT));       ENDW(t);   RESC(); ROT();
    STEP(pA0,pA1,pB0,pB1,t+1,(t+4<NT),(t+2<NT),(t+2<NT));     ENDW(t+1); RESC(); ROT();
  }
  STEP(pB0,pB1,pA0,pA1,NT-1,false,false,false); RESC();
  { float sacc=pB0[0]+pB0[1]; _Pragma("unroll") for(int r=2;r<16;++r)sacc+=pB0[r]; _Pragma("unroll") for(int r=0;r<16;++r)sacc+=pB1[r]; l_reg+=sacc;
    pw0=(u32x4){PKW(pB0,0),PKW(pB0,2),PKW(pB0,4),PKW(pB0,6)};pw1=(u32x4){PKW(pB0,8),PKW(pB0,10),PKW(pB0,12),PKW(pB0,14)};pw2=(u32x4){PKW(pB1,0),PKW(pB1,2),PKW(pB1,4),PKW(pB1,6)};pw3=(u32x4){PKW(pB1,8),PKW(pB1,10),PKW(pB1,12),PKW(pB1,14)};
    SBAR(); pv(o,vb0+2*sl_cur,PAF(0),PAF(1),PAF(2),PAF(3)); }
  #undef PKW
  #undef PAF
  #undef VFR
  #undef PIN
  #undef MX3
  #undef GAPA
  #undef GAPB2
  #undef VRD2
  #undef NORD
  #undef MF32
  #undef EX
  #undef VRD
  #undef KRD
  #undef STEP
  #undef ENDW
  {auto rr=__builtin_amdgcn_permlane32_swap(__float_as_uint(l_reg),__float_as_uint(l_reg),false,false);l_reg=__uint_as_float(rr[0])+__uint_as_float(rr[1]);}
  if(hi==0)wsf[32+r32]=l_reg;asm volatile("s_waitcnt lgkmcnt(0)":::"memory");
  float rli[16];
  #pragma unroll
  for(int r=0;r<16;++r)rli[r]=__builtin_amdgcn_rcpf(wsf[32+crow(r,hi)]);
  bf16*Ow=O+(rowbase+q0+wid*QBLK)*OPITCH+ocol;
  { bf16*stg=(bf16*)(shm+LDS_OST)+wid*2048;
    #pragma unroll
    for(int hf=0;hf<2;++hf){
      #pragma unroll
      for(int r=0;r<16;++r){const int orow=crow(r,hi);
        #pragma unroll
        for(int d0=0;d0<2;++d0)stg[orow*64+d0*32+r32]=__float2bfloat16(o[2*hf+d0][r]*rli[r]);}
      asm volatile("s_waitcnt lgkmcnt(0)":::"memory");
      #pragma unroll
      for(int i=0;i<4;++i){const int row=i*8+(lane>>3),ch=lane&7; const u32x4 v=*(const u32x4*)(stg+row*64+ch*8); ATTN_STORE16(Ow+(long)row*OPITCH+hf*64+ch*8,v);}
      asm volatile("s_waitcnt lgkmcnt(0)":::"memory"); } }
  asm volatile("s_waitcnt lgkmcnt(0)\n\ts_barrier":::"memory");
  #undef DMA_K
  #undef DMA_V
  #undef CMASK
  #undef START
  #undef RESC
  #undef ROT
}
constexpr int ATTN_LDS_BYTES=LDS_BYTES;
struct AttnTensors { const bf16* Q; const bf16* K; const bf16* V; bf16* O; };
struct AttnUnit { int bhq; int qb; };
struct StaticOrder {
  int vcu;
  __device__ __forceinline__ explicit StaticOrder(int v):vcu(v){}
  __device__ __forceinline__ bool next(int i,AttnUnit&u)const{ if(i>=8)return false; const int s=vcu&7,ii=i&3; u.bhq=(vcu>>3)*2+(i>>2); u.qb=(ii==0)?s:(ii==1)?15-s:(ii==2)?16+s:31-s; return true; }
};
template<class Sched,int THRL=8> __device__ __forceinline__ void attn_phase(char*lds,const AttnTensors&T,const Sched&S){
  AttnUnit u;
  for(int i=0;S.next(i,u);++i){ const int b=u.bhq>>4, hq=u.bhq&15;
    attn_unit<THRL>(b,hq*64,(hq>>1)*128,hq*128,u.qb,T.Q,T.K,T.V,T.O,lds); }
}
#undef SBAR
#undef WAIT_BAR
}
constexpr int NWAVES = 8;
#ifndef MK_PER_PHASE
#define MK_PER_PHASE 0
#endif
constexpr int BATCH = 4, T = 8192, D = 2048, NL = 4, FF = 8192, NIN = 8192;
constexpr int M = BATCH * T;
constexpr int NG = 64, NP = 64, NH = 16;
constexpr int SSM_L = 64, NCH = T / SSM_L;
constexpr int KT_ROWS = SSM_L + 16;
constexpr float LN_EPS = 1e-5f, RMS_EPS = 1e-5f;
constexpr float ALPHA = 1.6817928305074292f;
constexpr int PH_PER_LAYER = 9, N_PHASES = 1 + NL * PH_PER_LAYER;

constexpr size_t MiB = 1u << 20;
constexpr size_t WS_CTL = 0, CTL_ZERO_BYTES = 1 * MiB;
constexpr size_t WS_ROPEC = 1 * MiB, WS_ROPES = 5 * MiB;
constexpr size_t WS_PTAB = 9 * MiB;
constexpr size_t WS_BBRE = 18 * MiB, WS_BBIM = 19 * MiB;
constexpr size_t WS_KTAB = 20 * MiB;
constexpr size_t WS_WE = 23 * MiB, WS_WC = 39 * MiB;
constexpr size_t WS_WIN = 56 * MiB, WS_WGLU = 88 * MiB, WS_WMRG = 90 * MiB, WS_WOUT = 98 * MiB, WS_W1 = 106 * MiB, WS_W2 = 138 * MiB;
constexpr size_t WS_XB = 170 * MiB;
constexpr size_t WS_Q = 298 * MiB, WS_K = 362 * MiB, WS_V = 426 * MiB, WS_U = 490 * MiB, WS_GA = 554 * MiB, WS_GS = 682 * MiB;
constexpr size_t WS_H = 298 * MiB;
constexpr size_t WS_AS = 810 * MiB;
constexpr size_t WS_GACT = 938 * MiB;
constexpr size_t WS_END = 1002 * MiB;
static_assert(WS_PTAB + (size_t)NL * NG * 65 * NP * 8 <= WS_BBRE && WS_KTAB + (size_t)NG * KT_ROWS * 512 <= WS_WE && WS_W2 + (size_t)D * FF * 2 <= WS_XB && WS_GS + (size_t)M * 2048 * 2 <= WS_AS && WS_H + (size_t)M * FF * 2 <= WS_AS, "d_ws map");
constexpr int CW_TMO = 0, CW_CODE = 1;
constexpr int CW_BAR = 4096;

constexpr int RING_OFF = 0, RING_BYTES = 131072;
constexpr int LDSCTL_OFF = RING_BYTES, MISC_OFF = LDSCTL_OFF + 320;
constexpr int LDS_BYTES = 147456;
#define GAS __attribute__((address_space(1)))
#define LAS __attribute__((address_space(3)))
typedef unsigned short bf16;
typedef unsigned v4u __attribute__((ext_vector_type(4)));
typedef float f32x4 __attribute__((ext_vector_type(4)));
typedef short bf16x8 __attribute__((ext_vector_type(8)));
typedef GAS unsigned gu32;
typedef GAS unsigned long long gu64;
#define RLX_AGENT __ATOMIC_RELAXED, __HIP_MEMORY_SCOPE_AGENT
#define LDS_WAIT() asm volatile("s_waitcnt lgkmcnt(0)" ::: "memory")
#define VM_WAIT() asm volatile("s_waitcnt vmcnt(0)" ::: "memory")
__device__ __forceinline__ unsigned long long rt() { return __builtin_amdgcn_s_memrealtime(); }
__device__ __forceinline__ unsigned f2bf(float f) { unsigned u = __builtin_bit_cast(unsigned, f); return (u + 0x7fffu + ((u >> 16) & 1u)) >> 16; }
__device__ __forceinline__ unsigned pk2(float lo, float hi) { return f2bf(lo) | (f2bf(hi) << 16); }

#define XB_TMO      128
#define XB_XCNT(j)  (256  + 64 * (j))
#define XB_XSUB(j)  (1280 + 64 * (j))
#define XB_XGEN(j)  (2304 + 64 * (j))
#define XB_TOP      3328
#define XB_TOPGEN   3392
#define XCD_BAR_WORDS 3456
#define XB_SPIN_CAP (1u << 18)

__device__ __forceinline__ unsigned xb_ld(unsigned* p)              { return __hip_atomic_load(p, __ATOMIC_RELAXED, __HIP_MEMORY_SCOPE_AGENT); }
__device__ __forceinline__ unsigned xb_add(unsigned* p, unsigned v) { return __hip_atomic_fetch_add(p, v, __ATOMIC_RELAXED, __HIP_MEMORY_SCOPE_AGENT); }
__device__ __forceinline__ unsigned xb_xcc_id() { return (unsigned)__builtin_amdgcn_s_getreg((3 << 11) | 20) & 0xFu; }
#define XB_SPIN(cond, bar) do { unsigned _sp = 0; while (cond) { __builtin_amdgcn_s_sleep(1); \
    if ((++_sp & 255u) == 0u) { if (xb_ld(&(bar)[XB_TMO])) break; if (_sp > XB_SPIN_CAP) { atomicAdd(&(bar)[XB_TMO], 1u); break; } } } } while (0)

struct XcdBarrier {
    unsigned* bar; unsigned x;
    volatile LAS unsigned* st;
};

__device__ __forceinline__ XcdBarrier xcd_barrier_post(unsigned* bar, volatile LAS unsigned* st) {
    XcdBarrier b; b.bar = bar; b.x = xb_xcc_id(); b.st = st;
    if (threadIdx.x == 0) (void)xb_add(&bar[XB_XCNT(b.x)], 1u);
    return b;
}
__device__ __forceinline__ void xcd_barrier_complete(unsigned* bar, unsigned x, unsigned& nloc, unsigned& nx) {
    const unsigned G = gridDim.x * gridDim.y * gridDim.z;
    unsigned sum, cnt, mine, sp = 0u;
    for (;;) {
        sum = 0u; cnt = 0u; mine = 0u;
#pragma unroll
        for (unsigned j = 0; j < 16; ++j) { const unsigned c = xb_ld(&bar[XB_XCNT(j)]); sum += c; cnt += (c > 0u) ? 1u : 0u; mine = (j == x) ? c : mine; }
        if (sum == G) break;
        __builtin_amdgcn_s_sleep(1);
        if ((++sp & 255u) == 0u) { if (xb_ld(&bar[XB_TMO])) break; if (sp > XB_SPIN_CAP) { atomicAdd(&bar[XB_TMO], 1u); break; } }
    }
    nloc = mine > 0u ? mine : 1u; nx = cnt > 0u ? cnt : 1u;
}

__device__ __forceinline__ void xcd_barrier(const XcdBarrier& b) {
    asm volatile("s_waitcnt vmcnt(0)" ::: "memory");
    __syncthreads();
    if (threadIdx.x == 0) {
        unsigned* bar = b.bar;
        __builtin_amdgcn_s_waitcnt(0);
        unsigned nloc = b.st[0], nx = b.st[1];
        if (nloc == 0u) { xcd_barrier_complete(bar, b.x, nloc, nx); b.st[0] = nloc; b.st[1] = nx; }
        const unsigned old = xb_add(&bar[XB_XSUB(b.x)], 1u);
        const unsigned gen = old / nloc;
        if (old + 1u == (gen + 1u) * nloc) {
            __builtin_amdgcn_fence(__ATOMIC_RELEASE, "agent");
            asm volatile("s_waitcnt vmcnt(0)" ::: "memory");
            const unsigned og = xb_add(&bar[XB_TOP], 1u);
            const unsigned tg = og / nx;
            if (og + 1u == (tg + 1u) * nx) xb_add(&bar[XB_TOPGEN], 1u);
            else XB_SPIN(xb_ld(&bar[XB_TOPGEN]) == tg, bar);
            __builtin_amdgcn_fence(__ATOMIC_ACQUIRE, "agent");
            xb_add(&bar[XB_XGEN(b.x)], 1u);
            asm volatile("s_waitcnt vmcnt(0)" ::: "memory");
        } else {
            XB_SPIN(xb_ld(&bar[XB_XGEN(b.x)]) == gen, bar);
            __builtin_amdgcn_fence(__ATOMIC_ACQUIRE, "agent");
            asm volatile("s_waitcnt vmcnt(0)" ::: "memory");
        }
    }
    __syncthreads();
}
struct Frame {
    LAS unsigned char* lds;
    volatile LAS unsigned* MISC;
    gu32* ctl;
    int tid, lane, wave;
    int vcu, G;
    unsigned char* ws;
    const float* in[23];
    float* out;
};
__device__ __forceinline__ float wave_sum(float v) {
#pragma unroll
    for (int o = 1; o < 64; o <<= 1) v += __shfl_xor(v, o);
    return v;
}
__device__ __forceinline__ float bflo(unsigned u) { return __uint_as_float(u << 16); }
__device__ __forceinline__ float bfhi(unsigned u) { return __uint_as_float(u & 0xffff0000u); }

__device__ __forceinline__ void dsincos(double a, double& s, double& c) {
    const double q = __builtin_rint(a * 0.63661977236758134308);
    double r = __builtin_fma(-q, 1.57079632679489655800e+00, a); r = __builtin_fma(-q, 6.12323399573676603587e-17, r);
    const double z = r * r;
    double sp = -7.6471637318198164759e-13; sp = sp * z + 1.6059043836821614599e-10; sp = sp * z - 2.5052108385441718775e-08; sp = sp * z + 2.7557319223985890653e-06;
    sp = sp * z - 1.9841269841269841270e-04; sp = sp * z + 8.3333333333333333333e-03; sp = sp * z - 1.6666666666666666667e-01; const double sr = r + r * z * sp;
    double cp = 4.7794773323873852974e-14; cp = cp * z - 1.1470745597729724714e-11; cp = cp * z + 2.0876756987868098979e-09; cp = cp * z - 2.7557319223985890653e-07;
    cp = cp * z + 2.4801587301587301587e-05; cp = cp * z - 1.3888888888888888889e-03; cp = cp * z + 4.1666666666666666667e-02; cp = cp * z - 0.5; const double cr = 1.0 + z * cp;
    const int qi = (int)(long long)q & 3;
    s = (qi == 0) ? sr : (qi == 1) ? cr : (qi == 2) ? -sr : -cr;
    c = (qi == 0) ? cr : (qi == 1) ? -sr : (qi == 2) ? -cr : sr;
}
__device__ __forceinline__ double dexp(double x) {
    const double k = __builtin_rint(x * 1.44269504088896340736);
    double r = __builtin_fma(-k, 6.93147180369123816490e-01, x); r = __builtin_fma(-k, 1.90821492927058770002e-10, r);
    double p = 1.6059043836821614599e-10; p = p * r + 2.0876756987868098979e-09; p = p * r + 2.5052108385441718775e-08; p = p * r + 2.7557319223985890653e-07; p = p * r + 2.7557319223985890653e-06;
    p = p * r + 2.4801587301587301587e-05; p = p * r + 1.9841269841269841270e-04; p = p * r + 1.3888888888888888889e-03; p = p * r + 8.3333333333333333333e-03; p = p * r + 4.1666666666666666667e-02;
    p = p * r + 1.6666666666666666667e-01; p = p * r + 0.5; p = p * r + 1.0; p = p * r + 1.0;
    const long long e = (long long)k + 1023; return p * __builtin_bit_cast(double, (unsigned long long)e << 52);
}

template <bool PAIRED> __device__ __forceinline__ void transpose_item(const float* W, int K, int N, bf16* WT, int ldo, int col_off, LAS float* scr, int item, int lane) {
    const int nblk = N / 32, kb = item / nblk, nb = item % nblk, k0 = 64 * kb, n0 = 32 * nb;
#pragma unroll 8
    for (int i = 0; i < 32; ++i) { const int kk = 2 * i + (lane >> 5); scr[kk * 33 + (lane & 31)] = W[(size_t)(k0 + kk) * N + n0 + (lane & 31)]; }
    LDS_WAIT(); asm volatile("" ::: "memory");
    const int c = lane & 7;
#pragma unroll
    for (int j = 0; j < 4; ++j) { const int n = (lane >> 3) + 8 * j; const LAS float* s = scr + (8 * c) * 33 + n;
        v4u o; o.x = pk2(s[0 * 33], s[1 * 33]); o.y = pk2(s[2 * 33], s[3 * 33]); o.z = pk2(s[4 * 33], s[5 * 33]); o.w = pk2(s[6 * 33], s[7 * 33]);
        int nn = n0 + n; if (PAIRED && nn < 2048) { const int d = nn & 63; nn = (nn & ~63) + ((d < 32) ? 2 * d : 2 * (d - 32) + 1); }
        *(GAS v4u*)(WT + (size_t)nn * ldo + col_off + k0 + 8 * c) = o; }
    LDS_WAIT(); asm volatile("" ::: "memory");
}
__device__ __forceinline__ void convert_weights(Frame& F, int l) {
    LAS float* scr = (LAS float*)(F.lds + RING_OFF + F.wave * 16384);
    const int gw = F.vcu * NWAVES + F.wave, NGW = F.G * NWAVES;
    bf16* Win = (bf16*)(F.ws + WS_WIN); bf16* Wglu = (bf16*)(F.ws + WS_WGLU); bf16* Wmrg = (bf16*)(F.ws + WS_WMRG); bf16* Wout = (bf16*)(F.ws + WS_WOUT); bf16* W1 = (bf16*)(F.ws + WS_W1); bf16* W2 = (bf16*)(F.ws + WS_W2);
    const float* w_in = F.in[2] + (size_t)l * D * NIN; const float* w_glu = F.in[13] + (size_t)l * 1024 * 1024; const float* w_au = F.in[14] + (size_t)l * 1024 * D; const float* w_su = F.in[15] + (size_t)l * 1024 * D;
    const float* w_out = F.in[16] + (size_t)l * D * D; const float* w_1 = F.in[21] + (size_t)l * D * FF; const float* w_2 = F.in[22] + (size_t)l * FF * D;
    constexpr int I_IN = (D / 64) * (NIN / 32), I_GLU = (1024 / 64) * (1024 / 32), I_UP = (1024 / 64) * (D / 32), I_OUT = (D / 64) * (D / 32), I_1 = (D / 64) * (FF / 32), I_2 = (FF / 64) * (D / 32);
    constexpr int NITEMS = I_IN + I_GLU + 2 * I_UP + I_OUT + I_1 + I_2;
    for (int it = gw; it < NITEMS; it += NGW) {
        int r = it;
        if (r < I_IN) { transpose_item<true>(w_in, D, NIN, Win, D, 0, scr, r, F.lane); continue; } r -= I_IN;
        if (r < I_GLU) { transpose_item<false>(w_glu, 1024, 1024, Wglu, 1024, 0, scr, r, F.lane); continue; } r -= I_GLU;
        if (r < I_UP) { transpose_item<false>(w_au, 1024, D, Wmrg, 2048, 0, scr, r, F.lane); continue; } r -= I_UP;
        if (r < I_UP) { transpose_item<false>(w_su, 1024, D, Wmrg, 2048, 1024, scr, r, F.lane); continue; } r -= I_UP;
        if (r < I_OUT) { transpose_item<false>(w_out, D, D, Wout, D, 0, scr, r, F.lane); continue; } r -= I_OUT;
        if (r < I_1) { transpose_item<false>(w_1, D, FF, W1, D, 0, scr, r, F.lane); continue; } r -= I_1;
        transpose_item<false>(w_2, FF, D, W2, FF, 0, scr, r, F.lane);
    }
}

__device__ __forceinline__ void pro_phase(Frame& F) {
    const int gw = F.vcu * NWAVES + F.wave, NGW = F.G * NWAVES, lane = F.lane;
    {
        const int i = lane & 31; const double inv = dexp(-(double)(2 * i) * (9.21034037197618273607 / 64.0));
        const int* pos = (const int*)F.in[1]; float* rc = (float*)(F.ws + WS_ROPEC); float* rs = (float*)(F.ws + WS_ROPES);
        for (int m = gw; m < M; m += NGW) { double s, c; dsincos((double)pos[m] * inv, s, c); if (lane < 32) rc[(size_t)m * 32 + i] = (float)c; else rs[(size_t)m * 32 + i] = (float)s; }
    }
    {
        float* PT = (float*)(F.ws + WS_PTAB);
        for (int it = gw; it < NL * NG * 65; it += NGW) { const int lg = it / 65, tau = it % 65;
            const double dt = dexp((double)F.in[7][lg]), are = (double)F.in[5][lg * NP + lane], aim = (double)F.in[6][lg * NP + lane];
            const double mag = dexp((double)tau * dt * are); double s, c; dsincos((double)tau * dt * aim, s, c);
            *(float2*)(PT + ((size_t)it * NP + lane) * 2) = make_float2((float)(mag * c), (float)(mag * s)); }
    }
    {
        float* BR = (float*)(F.ws + WS_BBRE); float* BI = (float*)(F.ws + WS_BBIM);
        for (int lg = gw; lg < NL * NG; lg += NGW) {
            const double dt = dexp((double)F.in[7][lg]), are = (double)F.in[5][lg * NP + lane], aim = (double)F.in[6][lg * NP + lane];
            const double mag = dexp(dt * are); double s, c; dsincos(dt * aim, s, c);
            const double nr = mag * c - 1.0, ni = mag * s, den = are * are + aim * aim, zr = (nr * are + ni * aim) / den, zi = (ni * are - nr * aim) / den;
            const size_t o = ((size_t)lg * NP + lane) * NH;
#pragma unroll
            for (int h = 0; h < NH; ++h) { const double br = (double)F.in[8][o + h], bi = (double)F.in[9][o + h]; BR[o + h] = (float)(zr * br - zi * bi); BI[o + h] = (float)(zr * bi + zi * br); }
        }
    }
    {
        const GAS f32x4* x4 = (const GAS f32x4*)F.in[0]; GAS v4u* xb = (GAS v4u*)(F.ws + WS_XB);
        for (size_t i = (size_t)gw * 64 + lane; i < (size_t)M * D / 8; i += (size_t)NGW * 64) { const f32x4 a = x4[2 * i], b = x4[2 * i + 1]; v4u o; o.x = pk2(a.x, a.y); o.y = pk2(a.z, a.w); o.z = pk2(b.x, b.y); o.w = pk2(b.z, b.w); xb[i] = o; }
    }
    convert_weights(F, 0);
}

__device__ __forceinline__ void ssm_tables(Frame& F, int l) {
    const int gw = F.vcu * NWAVES + F.wave, NGW = F.G * NWAVES, lane = F.lane;
    const float* PT = (const float*)(F.ws + WS_PTAB) + (size_t)l * NG * 65 * NP * 2; const float* BR = (const float*)(F.ws + WS_BBRE) + (size_t)l * NG * NP * NH; const float* BI = (const float*)(F.ws + WS_BBIM) + (size_t)l * NG * NP * NH;
    const float* CR = F.in[10] + (size_t)l * NG * NH * NP; const float* CI = F.in[11] + (size_t)l * NG * NH * NP; const float* DS = F.in[12] + (size_t)l * NG * NH;
    bf16* WE = (bf16*)(F.ws + WS_WE); bf16* WC = (bf16*)(F.ws + WS_WC); bf16* KT = (bf16*)(F.ws + WS_KTAB);
    constexpr int I_WE = NG * 64, I_WC = NG * 64, I_KT = NG * KT_ROWS;
    for (int it = gw; it < I_WE + I_WC + I_KT; it += NGW) {
        if (it < I_WE) { const int g = it >> 6, j = it & 63;
#pragma unroll
            for (int e = 0; e < 2; ++e) { const int n = 2 * lane + e, p = n & 63, ri = n >> 6; const float2 pw = *(const float2*)(PT + ((size_t)(g * 65 + (63 - j)) * NP + p) * 2);
                const float* br = BR + ((size_t)g * NP + p) * NH; const float* bi = BI + ((size_t)g * NP + p) * NH; float v[16];
#pragma unroll
                for (int h = 0; h < 16; ++h) v[h] = ri ? (pw.x * bi[h] + pw.y * br[h]) : (pw.x * br[h] - pw.y * bi[h]);
                GAS v4u* o = (GAS v4u*)(WE + (((size_t)g * 64 + j) * 128 + n) * 16);
                v4u a, b; a.x = pk2(v[0], v[1]); a.y = pk2(v[2], v[3]); a.z = pk2(v[4], v[5]); a.w = pk2(v[6], v[7]); b.x = pk2(v[8], v[9]); b.y = pk2(v[10], v[11]); b.z = pk2(v[12], v[13]); b.w = pk2(v[14], v[15]); o[0] = a; o[1] = b; }
        } else if (it < I_WE + I_WC) { const int r = it - I_WE, g = r >> 6, j = r & 63;
            const int ho = lane >> 2, kq = lane & 3, ri = kq >> 1, p0 = (kq & 1) * 32;
            const float* cr = CR + ((size_t)g * NH + ho) * NP + p0; const float* ci = CI + ((size_t)g * NH + ho) * NP + p0; const float* pw = PT + ((size_t)(g * 65 + (j + 1)) * NP + p0) * 2;
            GAS v4u* o = (GAS v4u*)(WC + (((size_t)g * 1024 + j * 16 + ho) * 128 + kq * 32));
#pragma unroll
            for (int q = 0; q < 4; ++q) { float v[8];
#pragma unroll
                for (int e = 0; e < 8; ++e) { const int p = q * 8 + e; const float c_r = cr[p], c_i = ci[p], pr = pw[2 * p], pi = pw[2 * p + 1]; v[e] = ri ? -(c_r * pi + c_i * pr) : (c_r * pr - c_i * pi); }
                v4u a; a.x = pk2(v[0], v[1]); a.y = pk2(v[2], v[3]); a.z = pk2(v[4], v[5]); a.w = pk2(v[6], v[7]); o[q] = a; }
        } else { const int r = it - I_WE - I_WC, g = r / KT_ROWS, row = r % KT_ROWS, tau = row - 16;
            const int ho = lane >> 2, h0 = 4 * (lane & 3); float s0 = 0.f, s1 = 0.f, s2 = 0.f, s3 = 0.f;
            if (tau >= 0) {
                const float* cr = CR + ((size_t)g * NH + ho) * NP; const float* ci = CI + ((size_t)g * NH + ho) * NP; const float* pw = PT + ((size_t)(g * 65 + tau) * NP) * 2;
                for (int p = 0; p < NP; ++p) { const float c_r = cr[p], c_i = ci[p], pr = pw[2 * p], pi = pw[2 * p + 1], xr = c_r * pr - c_i * pi, xi = c_r * pi + c_i * pr;
                    const f32x4 br = *(const f32x4*)(BR + ((size_t)g * NP + p) * NH + h0), bi = *(const f32x4*)(BI + ((size_t)g * NP + p) * NH + h0);
                    s0 += xr * br.x - xi * bi.x; s1 += xr * br.y - xi * bi.y; s2 += xr * br.z - xi * bi.z; s3 += xr * br.w - xi * bi.w; }
                if (tau == 0) { const float d = DS[g * NH + ho]; if (ho == h0) s0 += d; if (ho == h0 + 1) s1 += d; if (ho == h0 + 2) s2 += d; if (ho == h0 + 3) s3 += d; }
            }
            *(GAS unsigned long long*)(KT + ((size_t)(g * KT_ROWS + row) * 256 + lane * 4)) = (unsigned long long)pk2(s0, s1) | ((unsigned long long)pk2(s2, s3) << 32);
        }
    }
}

typedef float f32x16 __attribute__((ext_vector_type(16)));
__device__ __forceinline__ int crow16(int r, int hi) { return (r & 3) + 8 * (r >> 2) + 4 * hi; }
constexpr int SSM_E_STRIDE = 132, SSM_HP_STRIDE = 136;
constexpr int SSM_E_OFF = 0, SSM_HP_OFF = 128 * SSM_E_STRIDE * 4, SSM_KT_OFF = 0;
static_assert(SSM_HP_OFF + 128 * SSM_HP_STRIDE * 2 <= RING_BYTES && KT_ROWS * 512 <= SSM_HP_OFF, "ssm LDS map");
__device__ __forceinline__ void ssm_unit(Frame& F, int l, int b, int g) {
    const int lane = F.lane, wid = F.wave, r32 = lane & 31, hi = lane >> 5, rt = wid & 3, ng = wid >> 2;
    const bf16* Ug = (const bf16*)(F.ws + WS_U) + ((size_t)g * M + (size_t)b * T) * 16;
    const bf16* WEg = (const bf16*)(F.ws + WS_WE) + (size_t)g * 64 * 128 * 16;
    const bf16* WCg = (const bf16*)(F.ws + WS_WC) + (size_t)g * 1024 * 128;
    const bf16* KTg = (const bf16*)(F.ws + WS_KTAB) + (size_t)g * KT_ROWS * 256;
    LAS float* E = (LAS float*)(F.lds + SSM_E_OFF); LAS bf16* HP = (LAS bf16*)(F.lds + SSM_HP_OFF); LAS unsigned char* KTl = F.lds + SSM_KT_OFF;
    const bf16* ua = Ug + ((size_t)(32 * rt + r32) * 64) * 16 + 8 * hi;
    {
        const bf16* wb = WEg + (size_t)(64 * ng + r32) * 16 + 8 * hi;
        f32x16 e0 = {}, e1 = {};
#pragma unroll 8
        for (int j = 0; j < 64; ++j) { const bf16x8 a = *(const bf16x8*)(ua + j * 16), b0 = *(const bf16x8*)(wb + j * 2048), b1 = *(const bf16x8*)(wb + j * 2048 + 512);
            e0 = __builtin_amdgcn_mfma_f32_32x32x16_bf16(a, b0, e0, 0, 0, 0); e1 = __builtin_amdgcn_mfma_f32_32x32x16_bf16(a, b1, e1, 0, 0, 0); }
#pragma unroll
        for (int r = 0; r < 16; ++r) { LAS float* row = E + (32 * rt + crow16(r, hi)) * SSM_E_STRIDE + 64 * ng + r32; row[0] = e0[r]; row[32] = e1[r]; }
    }
    __syncthreads();
    if (wid == 0) {
        const float2 al = *(const float2*)((const float*)(F.ws + WS_PTAB) + (((size_t)(l * NG + g) * 65 + 64) * NP + lane) * 2);
        float hr = 0.f, hi_ = 0.f;
#pragma unroll 8
        for (int c = 0; c < NCH; ++c) { HP[c * SSM_HP_STRIDE + lane] = (bf16)f2bf(hr); HP[c * SSM_HP_STRIDE + 64 + lane] = (bf16)f2bf(hi_);
            const float er = E[c * SSM_E_STRIDE + lane], ei = E[c * SSM_E_STRIDE + 64 + lane];
            const float nr = al.x * hr - al.y * hi_ + er, ni = al.x * hi_ + al.y * hr + ei; hr = nr; hi_ = ni; }
    }
    __syncthreads();
    for (int i = F.tid; i < KT_ROWS * 512 / 16; i += NWAVES * 64) *(LAS v4u*)(KTl + i * 16) = *(const GAS v4u*)((const GAS unsigned char*)KTg + (size_t)i * 16);
    __syncthreads();
    {
        bf16x8 hf[8];
#pragma unroll
        for (int ks = 0; ks < 8; ++ks) hf[ks] = *(const LAS bf16x8*)(HP + (32 * rt + r32) * SSM_HP_STRIDE + 16 * ks + 8 * hi);
        const int jj = r32 >> 4, ho = r32 & 15;
        const LAS unsigned char* ktl = KTl + (jj + 16) * 512 + ho * 32 + hi * 16;
        bf16* gact = (bf16*)(F.ws + WS_GACT) + ((size_t)b * T + (size_t)(32 * rt) * 64 + jj) * 1024 + 16 * g + ho;
        for (int q = 0; q < 4; ++q) {
            f32x16 acc[4];
#pragma unroll
            for (int k = 0; k < 4; ++k) acc[k] = (f32x16){};
#pragma unroll
            for (int k = 0; k < 4; ++k) { const int jp = 8 * q + 2 * k + ng; const bf16* wc = WCg + (size_t)(32 * jp + r32) * 128 + 8 * hi;
                bf16x8 wf[8];
#pragma unroll
                for (int ks = 0; ks < 8; ++ks) wf[ks] = *(const bf16x8*)(wc + 16 * ks);
#pragma unroll
                for (int ks = 0; ks < 8; ++ks) acc[k] = __builtin_amdgcn_mfma_f32_32x32x16_bf16(hf[ks], wf[ks], acc[k], 0, 0, 0);
                asm volatile("" ::: "memory"); }
            const int NI = 16 * q + 16, jb = 2 * (8 * q + ng);
            bf16x8 A0[4], A1[4];
#define SSM_LDA(dst, ib) do { _Pragma("unroll") for (int e = 0; e < 4; ++e) dst[e] = *(const bf16x8*)(ua + ((ib) + e) * 16); } while (0)
#define SSM_CMP(src, ib) do { _Pragma("unroll") for (int e = 0; e < 4; ++e) { const LAS unsigned char* kp = ktl + (jb - ((ib) + e)) * 512; _Pragma("unroll") for (int k = 0; k < 4; ++k) { \
                const bf16x8 kf = *(const LAS bf16x8*)(kp + k * 2048); acc[k] = __builtin_amdgcn_mfma_f32_32x32x16_bf16(src[e], kf, acc[k], 0, 0, 0); } } } while (0)
            SSM_LDA(A0, 0);
            for (int ib = 0; ib < NI; ib += 8) { SSM_LDA(A1, ib + 4); SSM_CMP(A0, ib); if (ib + 8 < NI) SSM_LDA(A0, ib + 8); SSM_CMP(A1, ib + 4); }
#undef SSM_LDA
#undef SSM_CMP
#pragma unroll
            for (int k = 0; k < 4; ++k) { const int jp = 8 * q + 2 * k + ng;
#pragma unroll
                for (int r = 0; r < 16; ++r) { const float y = acc[k][r], u2 = 1.5957691216057308f * (y + 0.044715f * y * y * y);
                    const float gl = y * __builtin_amdgcn_rcpf(1.0f + __builtin_amdgcn_exp2f(-1.4426950408889634f * u2));
                    gact[(size_t)(crow16(r, hi) * 64 + 2 * jp) * 1024] = (bf16)f2bf(gl); } }
        }
    }
    __syncthreads();
}

__device__ __forceinline__ void combine_phase(Frame& F, int l) {
    const int gw = F.vcu * NWAVES + F.wave, NGW = F.G * NWAVES, lane = F.lane;
    const float* lq = F.in[3] + l * 256;
    const float s1 = wave_sum(lq[lane] * lq[64 + lane]), s2 = wave_sum(lq[128 + lane] * lq[192 + lane]);
    const float lam_init = 0.8f - 0.6f * __expf(-0.3f * (float)l), lam = __expf(s1) - __expf(s2) + lam_init, post = 1.0f - lam_init;
    const int h = lane >> 3, e0 = (lane & 7) * 16;
    float gs[16];
#pragma unroll
    for (int e = 0; e < 16; ++e) gs[e] = F.in[4][l * 128 + e0 + e] * post;
    const bf16* O4 = (const bf16*)(F.ws + WS_XB); bf16* AS = (bf16*)(F.ws + WS_AS);
    for (int m = gw; m < M; m += NGW) {
        const GAS v4u* p0 = (const GAS v4u*)(O4 + (size_t)m * 2048 + (h * 2) * 128 + e0); const GAS v4u* p1 = (const GAS v4u*)(O4 + (size_t)m * 2048 + (h * 2 + 1) * 128 + e0);
        const v4u a0 = p0[0], a1 = p0[1], b0 = p1[0], b1 = p1[1];
        float d[16];
        d[0] = bflo(a0.x) - lam * bflo(b0.x); d[1] = bfhi(a0.x) - lam * bfhi(b0.x); d[2] = bflo(a0.y) - lam * bflo(b0.y); d[3] = bfhi(a0.y) - lam * bfhi(b0.y);
        d[4] = bflo(a0.z) - lam * bflo(b0.z); d[5] = bfhi(a0.z) - lam * bfhi(b0.z); d[6] = bflo(a0.w) - lam * bflo(b0.w); d[7] = bfhi(a0.w) - lam * bfhi(b0.w);
        d[8] = bflo(a1.x) - lam * bflo(b1.x); d[9] = bfhi(a1.x) - lam * bfhi(b1.x); d[10] = bflo(a1.y) - lam * bflo(b1.y); d[11] = bfhi(a1.y) - lam * bfhi(b1.y);
        d[12] = bflo(a1.z) - lam * bflo(b1.z); d[13] = bfhi(a1.z) - lam * bfhi(b1.z); d[14] = bflo(a1.w) - lam * bflo(b1.w); d[15] = bfhi(a1.w) - lam * bfhi(b1.w);
        float ss = 0.f;
#pragma unroll
        for (int e = 0; e < 16; ++e) ss += d[e] * d[e];
        ss += __shfl_xor(ss, 1); ss += __shfl_xor(ss, 2); ss += __shfl_xor(ss, 4);
        const float rs = 1.0f / sqrtf(ss * (1.0f / 128.0f) + RMS_EPS);
        v4u o0, o1;
        o0.x = pk2(d[0] * rs * gs[0], d[1] * rs * gs[1]); o0.y = pk2(d[2] * rs * gs[2], d[3] * rs * gs[3]); o0.z = pk2(d[4] * rs * gs[4], d[5] * rs * gs[5]); o0.w = pk2(d[6] * rs * gs[6], d[7] * rs * gs[7]);
        o1.x = pk2(d[8] * rs * gs[8], d[9] * rs * gs[9]); o1.y = pk2(d[10] * rs * gs[10], d[11] * rs * gs[11]); o1.z = pk2(d[12] * rs * gs[12], d[13] * rs * gs[13]); o1.w = pk2(d[14] * rs * gs[14], d[15] * rs * gs[15]);
        GAS v4u* po = (GAS v4u*)(AS + (size_t)m * 2048 + h * 128 + e0); po[0] = o0; po[1] = o1;
    }
}

__device__ __forceinline__ void ln_phase(Frame& F, const float* gam, const float* bet) {
    const int gw = F.vcu * NWAVES + F.wave, NGW = F.G * NWAVES, lane = F.lane;
    f32x4 gv[8], bv[8];
#pragma unroll
    for (int j = 0; j < 8; ++j) { gv[j] = ((const GAS f32x4*)gam)[64 * j + lane]; bv[j] = ((const GAS f32x4*)bet)[64 * j + lane]; }
    bf16* XB = (bf16*)(F.ws + WS_XB);
    for (int m = gw; m < M; m += NGW) {
        GAS f32x4* xr = (GAS f32x4*)(F.out + (size_t)m * D) + lane;
        f32x4 v[8]; float s = 0.f;
#pragma unroll
        for (int j = 0; j < 8; ++j) { v[j] = xr[64 * j]; s += (v[j].x + v[j].y) + (v[j].z + v[j].w); }
        const float mean = wave_sum(s) * (1.f / D); float s2 = 0.f;
#pragma unroll
        for (int j = 0; j < 8; ++j) { v[j] = v[j] - mean; s2 += (v[j].x * v[j].x + v[j].y * v[j].y) + (v[j].z * v[j].z + v[j].w * v[j].w); }
        const float rstd = 1.f / sqrtf(wave_sum(s2) * (1.f / D) + LN_EPS);
        GAS unsigned long long* o8 = (GAS unsigned long long*)(XB + (size_t)m * D) + lane;
#pragma unroll
        for (int j = 0; j < 8; ++j) { f32x4 o = v[j] * rstd * gv[j] + bv[j];
#ifdef DBG_SANITIZE
            for (int e = 0; e < 4; ++e) if (!(fabsf(o[e]) < 1e30f)) o[e] = 1000.0f;
#endif
            xr[64 * j] = o; o8[64 * j] = (unsigned long long)pk2(o.x, o.y) | ((unsigned long long)pk2(o.z, o.w) << 32); }
    }
}

struct Args { const float* in[23]; float* out; unsigned char* ws; int ph_lo, ph_hi; };
__global__ void __launch_bounds__(NWAVES * 64, 2) mk_fwd(Args args) {
    extern __shared__ __attribute__((aligned(16))) unsigned char lds[];
    Frame F;
    F.lds = (LAS unsigned char*)lds;
    F.MISC = (volatile LAS unsigned*)(F.lds + MISC_OFF);
    F.tid = threadIdx.x; F.lane = F.tid & 63; F.wave = __builtin_amdgcn_readfirstlane(F.tid >> 6);
    F.G = gridDim.x; { const int bx = blockIdx.x; F.vcu = (F.G % 8 == 0) ? (bx % 8) * (F.G / 8) + bx / 8 : bx; }
    F.ws = args.ws; F.ctl = (gu32*)(args.ws + WS_CTL); F.out = args.out;
#pragma unroll
    for (int i = 0; i < 23; ++i) F.in[i] = args.in[i];
    for (int u = F.tid; u < (LDS_BYTES - LDSCTL_OFF) / 4; u += NWAVES * 64) ((LAS unsigned*)(F.lds + LDSCTL_OFF))[u] = 0u;
    __syncthreads();
    XcdBarrier bar; bar.bar = (unsigned*)(F.ctl + CW_BAR); bar.x = 0; bar.st = nullptr;
    if (!MK_PER_PHASE) bar = xcd_barrier_post((unsigned*)(F.ctl + CW_BAR), F.MISC + 8);
    const int lo = args.ph_lo, hi = args.ph_hi;
#ifndef PM
#define PM 0x3ff
#endif
#define PMK(j) (((PM) >> (j)) & 1)
#ifndef DUP
#define DUP 0
#endif
#define REP(j) for (int rep_ = 0; rep_ < ((((DUP) >> (j)) & 1) + 1); ++rep_)
#define IN(k) (lo <= (k) && (k) < hi)
#define REFRESH() do { F.tid = opaque_tid(); F.lane = F.tid & 63; F.wave = __builtin_amdgcn_readfirstlane(F.tid >> 6); } while (0)
#define SEAM(k) do { if (IN((k) + 1)) xcd_barrier(bar); } while (0)

    bf16* const Win = (bf16*)(F.ws + WS_WIN); bf16* const Wglu = (bf16*)(F.ws + WS_WGLU); bf16* const Wmrg = (bf16*)(F.ws + WS_WMRG); bf16* const Wout = (bf16*)(F.ws + WS_WOUT); bf16* const W1 = (bf16*)(F.ws + WS_W1); bf16* const W2 = (bf16*)(F.ws + WS_W2);
    bf16* const XB = (bf16*)(F.ws + WS_XB); bf16* const Qb = (bf16*)(F.ws + WS_Q); bf16* const Kb = (bf16*)(F.ws + WS_K); bf16* const Vb = (bf16*)(F.ws + WS_V); bf16* const Ub = (bf16*)(F.ws + WS_U);
    bf16* const GA = (bf16*)(F.ws + WS_GA); bf16* const GS = (bf16*)(F.ws + WS_GS); bf16* const HB = (bf16*)(F.ws + WS_H); bf16* const AS = (bf16*)(F.ws + WS_AS); bf16* const GACT = (bf16*)(F.ws + WS_GACT);

    if (PMK(0) && IN(0)) { REFRESH(); pro_phase(F); SEAM(0); }

    for (int l = 0; l < NL; ++l) {
        const int p0 = 1 + l * PH_PER_LAYER;
        if (PMK(1) && IN(p0 + 0)) { REFRESH();
            ssm_tables(F, l);
            REP(1) {
            pg8::Gemm g{XB, Win, M, NIN, D}; pg8::StaticOrder S; S.init(M, NIN, F.G, (int)blockIdx.x);
            pg8::EpiInProj E{Qb, Kb, Vb, Ub, GA, GS, (const float*)(F.ws + WS_ROPEC), (const float*)(F.ws + WS_ROPES)};
            pg8::gemm_phase<pg8::EpiInProj, pg8::StaticOrder, true, true>(F.lds + RING_OFF, g, S, E);
            }
            SEAM(p0 + 0);
        }
        if (PMK(2) && IN(p0 + 1)) { REFRESH();
#ifdef DBG_NO_SSM
            { GAS v4u* z = (GAS v4u*)GACT; for (size_t i = (size_t)(F.vcu * NWAVES + F.wave) * 64 + F.lane; i < (size_t)M * 1024 / 8; i += (size_t)F.G * NWAVES * 64) z[i] = (v4u){0u, 0u, 0u, 0u}; }
#else
            REP(10) { for (int u = F.vcu; u < BATCH * NG; u += F.G) ssm_unit(F, l, u & 3, u >> 2); }
#endif
#ifdef DBG_NO_ATTN
            { GAS v4u* z = (GAS v4u*)XB; for (size_t i = (size_t)(F.vcu * NWAVES + F.wave) * 64 + F.lane; i < (size_t)M * 2048 / 8; i += (size_t)F.G * NWAVES * 64) z[i] = (v4u){0u, 0u, 0u, 0u}; }
#else
            const attn_body::AttnTensors AT{(const attn_body::bf16*)Qb, (const attn_body::bf16*)Kb, (const attn_body::bf16*)Vb, (attn_body::bf16*)XB};
            const attn_body::StaticOrder S(F.vcu);
            REP(2) { attn_body::attn_phase<attn_body::StaticOrder>((char*)lds + RING_OFF, AT, S); }
#endif
            SEAM(p0 + 1);
        }
        if (PMK(3) && IN(p0 + 2)) { REFRESH();
            REP(11) { combine_phase(F, l); }
            REP(3) {
            pg8::Gemm g{GACT, Wglu, M, 1024, 1024}; pg8::StaticOrder S; S.init(M, 1024, F.G, (int)blockIdx.x);
            pg8::EpiGlu E{GACT, AS};
            pg8::gemm_phase<pg8::EpiGlu, pg8::StaticOrder, true, true>(F.lds + RING_OFF, g, S, E);
            }
            SEAM(p0 + 2);
        }
        if (PMK(4) && IN(p0 + 3)) { REFRESH();
            pg8::Gemm g{AS, Wmrg, M, D, 2048}; pg8::StaticOrder S; S.init(M, D, F.G, (int)blockIdx.x);
            pg8::EpiMerge E{GA, GS};
            pg8::gemm_phase<pg8::EpiMerge, pg8::StaticOrder, true, true>(F.lds + RING_OFF, g, S, E);
            SEAM(p0 + 3);
        }
        if (PMK(5) && IN(p0 + 4)) { REFRESH();
            pg8::Gemm g{GA, Wout, M, D, D}; pg8::StaticOrder S; S.init(M, D, F.G, (int)blockIdx.x);
            pg8::EpiResF32 E{l == 0 ? F.in[0] : F.out, F.out, ALPHA};
            pg8::gemm_phase<pg8::EpiResF32, pg8::StaticOrder, true, true>(F.lds + RING_OFF, g, S, E);
            SEAM(p0 + 4);
        }
        if (PMK(6) && IN(p0 + 5)) { REFRESH(); ln_phase(F, F.in[17] + l * D, F.in[18] + l * D); SEAM(p0 + 5); }
        if (PMK(7) && IN(p0 + 6)) { REFRESH();
            REP(7) {
            pg8::Gemm g{XB, W1, M, FF, D}; pg8::StaticOrder S; S.init(M, FF, F.G, (int)blockIdx.x);
            pg8::EpiRelu2 E{HB};
            pg8::gemm_phase<pg8::EpiRelu2, pg8::StaticOrder, true, true>(F.lds + RING_OFF, g, S, E);
            }
            SEAM(p0 + 6);
        }
        if (PMK(8) && IN(p0 + 7)) { REFRESH();
            pg8::Gemm g{HB, W2, M, D, FF}; pg8::StaticOrder S; S.init(M, D, F.G, (int)blockIdx.x);
            pg8::EpiResF32 E{F.out, F.out, ALPHA};
            pg8::gemm_phase<pg8::EpiResF32, pg8::StaticOrder, true, true>(F.lds + RING_OFF, g, S, E);
            SEAM(p0 + 7);
        }
        if (PMK(9) && IN(p0 + 8)) { REFRESH();
            ln_phase(F, F.in[19] + l * D, F.in[20] + l * D);
            if (l + 1 < NL) { __syncthreads(); convert_weights(F, l + 1); }
            if (l + 1 < NL) SEAM(p0 + 8);
        }
    }
#undef IN
#undef SEAM
}

#ifdef DBG_DIAG
__global__ void diag_sum(const unsigned* p, size_t nwords, unsigned long long* slot) {
    unsigned long long s = 0; for (size_t i = (size_t)blockIdx.x * blockDim.x + threadIdx.x; i < nwords; i += (size_t)gridDim.x * blockDim.x) s += (unsigned long long)p[i] * (1u + (unsigned)(i & 1023u));
    for (int o = 1; o < 64; o <<= 1) s += __shfl_xor(s, o);
    if ((threadIdx.x & 63) == 0) atomicAdd(slot, s);
}
__global__ void diag_fill(float* out, size_t n, const unsigned long long* chk) {
    for (size_t i = (size_t)blockIdx.x * blockDim.x + threadIdx.x; i < n; i += (size_t)gridDim.x * blockDim.x) {
        int r = 0; size_t lo = 0, sz = n / 8 * 7; while (r < 6 && i >= lo + sz) { lo += sz; sz /= 8; ++r; }
        unsigned long long h = chk[r] ^ ((unsigned long long)i * 0x9E3779B97F4A7C15ull); h ^= h >> 29; h *= 0xBF58476D1CE4E5B9ull; h ^= h >> 32;
        out[i] = 1.0f + (float)(h & 0xFFFF) * (1.0f / 65536.0f);
    }
}
#endif
extern "C" void kernel_launch(void* const* d_in, const int* in_sizes, int n_in, void* d_out, int out_size, void* d_ws, size_t ws_size, hipStream_t stream) {
    static int grid = 0;
    if (grid == 0) {
        if (n_in != 23 || in_sizes[0] != M * D || out_size != M * D || ws_size < WS_END) { fprintf(stderr, "kernel_launch: unexpected problem shape (n_in %d, in0 %d, out %d, ws %zu); nothing launched\n", n_in, n_in > 0 ? in_sizes[0] : -1, out_size, ws_size); grid = -1; return; }
        int dev = 0, cus = 0, per_cu = 0;
        if (hipGetDevice(&dev) != hipSuccess || hipDeviceGetAttribute(&cus, hipDeviceAttributeMultiprocessorCount, dev) != hipSuccess) { grid = -1; return; }
        if (hipFuncSetAttribute((const void*)mk_fwd, hipFuncAttributeMaxDynamicSharedMemorySize, LDS_BYTES) != hipSuccess) { fprintf(stderr, "kernel_launch: hipFuncSetAttribute failed\n"); grid = -1; return; }
        if (hipOccupancyMaxActiveBlocksPerMultiprocessor(&per_cu, (const void*)mk_fwd, NWAVES * 64, LDS_BYTES) != hipSuccess || per_cu < 1) { fprintf(stderr, "kernel_launch: occupancy query reports %d workgroups per CU\n", per_cu); }
        (void)hipGetLastError();
        grid = cus;
    }
    if (grid < 0) return;
    if (hipMemsetAsync((char*)d_ws + WS_CTL, 0, CTL_ZERO_BYTES, stream) != hipSuccess) return;
    Args a{};
    for (int i = 0; i < 23; ++i) a.in[i] = (const float*)d_in[i];
    a.out = (float*)d_out; a.ws = (unsigned char*)d_ws;
#if MK_PER_PHASE
#ifdef DBG_DIAG
    unsigned long long* chk = (unsigned long long*)((char*)d_ws + 512 * 1024);
    auto SUM = [&](size_t off_mib, size_t len_mib, int r) { hipLaunchKernelGGL(diag_sum, dim3(2048), dim3(256), 0, stream, (const unsigned*)((char*)d_ws + off_mib * MiB), len_mib * MiB / 4, chk + r); };
    auto SUMO = [&](int r) { hipLaunchKernelGGL(diag_sum, dim3(2048), dim3(256), 0, stream, (const unsigned*)d_out, (size_t)M * D, chk + r); };
    auto RUN = [&](int p) { a.ph_lo = p; a.ph_hi = p + 1; hipLaunchKernelGGL(mk_fwd, dim3(grid), dim3(NWAVES * 64), LDS_BYTES, stream, a); };
    RUN(0); RUN(7); SUM(298, 512, 0);
    RUN(1); SUM(682, 128, 1); SUM(554, 128, 2); SUM(490, 64, 3); SUM(426, 64, 4); SUM(362, 64, 5); SUM(298, 64, 6);
    hipLaunchKernelGGL(diag_fill, dim3(2048), dim3(256), 0, stream, (float*)d_out, (size_t)M * D, (const unsigned long long*)chk);
#else
    for (int p = 0; p < N_PHASES; ++p) { a.ph_lo = p; a.ph_hi = p + 1; hipLaunchKernelGGL(mk_fwd, dim3(grid), dim3(NWAVES * 64), LDS_BYTES, stream, a); }
#endif
#else
    a.ph_lo = 0; a.ph_hi = N_PHASES;
    hipLaunchKernelGGL(mk_fwd, dim3(grid), dim3(NWAVES * 64), LDS_BYTES, stream, a);
#endif
    const hipError_t le = hipPeekAtLastError();
    if (le != hipSuccess) fprintf(stderr, "kernel_launch: launch failed: %s\n", hipGetErrorName(le));
}
```
